# Optimizing an MI355X kernel written in HIP

```python
import jax, jax.numpy as jnp
from jax import lax
import numpy as np

D_MODEL = 4096
BATCH = 1
SEQ = 8192
DEPTH = 2
DEC_BATCH = 8
DEC_SEQ = 64
PAST_LEN = 4096

CHUNK = 64
WINDOW = 128
WIN_CHUNKS = WINDOW // CHUNK
ATTN_WIDTH = D_MODEL // 2
POOL_WIDTH = D_MODEL - ATTN_WIDTH
HEAD_DIM = 64
N_HEADS = ATTN_WIDTH // HEAD_DIM
N_KV_HEADS = N_HEADS // 8
GROUP = N_HEADS // N_KV_HEADS
KV_WIDTH = N_KV_HEADS * HEAD_DIM
POOL_WINDOWS = (2, 4, 8, 16)
N_POOL_GROUPS = len(POOL_WINDOWS)
POOL_GROUP_WIDTH = POOL_WIDTH // N_POOL_GROUPS
POOL_STATE = max(POOL_WINDOWS) - 1
IN_WIDTH = ATTN_WIDTH + 2 * KV_WIDTH + POOL_WIDTH
N_MEM = 256
MEM_HEADS = 4
MEM_HEAD_DIM = 128
MEM_WIDTH = MEM_HEADS * MEM_HEAD_DIM
D_FF = -(-8 * D_MODEL // (3 * 256)) * 256
EPS = 1e-6
NEG_INF = -1e30

kernel_name = "hybrid_swa_sink_pool_stream_step"


def rms_norm(x, g):
    xf = x.astype(jnp.float32)
    y = xf * lax.rsqrt(jnp.mean(xf * xf, axis=-1, keepdims=True) + EPS)
    return (y * g.astype(jnp.float32)).astype(x.dtype)


def alibi_slopes():
    return 2.0 ** (-8.0 * jnp.arange(1, N_HEADS + 1, dtype=jnp.float32) / N_HEADS)


def chunk_band_mask(q_pos, k_pos):
    qc = q_pos[:, :, None] // CHUNK
    kc = k_pos[:, None, :] // CHUNK
    return (k_pos[:, None, :] >= 0) & (kc <= qc) & (kc >= qc - WIN_CHUNKS)


def sink_attention(q, k, v, q_pos, k_pos, sinks):
    f32 = jnp.float32
    s = jnp.einsum('bnqhgd,bnkhd->bnhgqk', q.astype(f32), k.astype(f32)) * (HEAD_DIM ** -0.5)
    dist = jnp.abs(q_pos[:, :, None] - k_pos[:, None, :]).astype(f32)
    slopes = alibi_slopes().reshape(N_KV_HEADS, GROUP, 1, 1)
    s = s - slopes * dist[None, :, None, None]
    s = jnp.where(chunk_band_mask(q_pos, k_pos)[None, :, None, None], s, NEG_INF)
    sink = sinks.astype(f32).reshape(N_KV_HEADS, GROUP, 1, 1)
    m = jnp.maximum(jnp.max(s, axis=-1, keepdims=True), sink)
    p = jnp.exp(s - m)
    denom = jnp.sum(p, axis=-1, keepdims=True) + jnp.exp(sink - m)
    o = jnp.einsum('bnhgqk,bnkhd->bnqhgd', p / denom, v.astype(f32))
    return o.astype(q.dtype)


def band_blocks(k):
    B, T = k.shape[:2]
    nC = T // CHUNK
    kp = jnp.pad(k, ((0, 0), (WINDOW, 0), (0, 0), (0, 0)))
    kp = kp.reshape(B, nC + WIN_CHUNKS, CHUNK, N_KV_HEADS, HEAD_DIM)
    return jnp.concatenate([kp[:, j:j + nC] for j in range(WIN_CHUNKS + 1)], axis=2)


def split_mixer_input(h, w_in, q_gain, k_gain):
    B, T, _ = h.shape
    z = h @ w_in
    q = rms_norm(z[..., :ATTN_WIDTH].reshape(B, T, N_KV_HEADS, GROUP, HEAD_DIM), q_gain)
    k = rms_norm(z[..., ATTN_WIDTH:ATTN_WIDTH + KV_WIDTH].reshape(B, T, N_KV_HEADS, HEAD_DIM), k_gain)
    v = z[..., ATTN_WIDTH + KV_WIDTH:ATTN_WIDTH + 2 * KV_WIDTH].reshape(B, T, N_KV_HEADS, HEAD_DIM)
    u = z[..., ATTN_WIDTH + 2 * KV_WIDTH:]
    return q, k, v, u


def swa_prompt(q, k, v, sinks):
    B, T = q.shape[:2]
    nC = T // CHUNK
    q_pos = jnp.arange(T, dtype=jnp.int32).reshape(nC, CHUNK)
    k_pos = (jnp.arange(nC, dtype=jnp.int32)[:, None] * CHUNK - WINDOW
             + jnp.arange(WINDOW + CHUNK, dtype=jnp.int32)[None, :])
    o = sink_attention(q.reshape(B, nC, CHUNK, N_KV_HEADS, GROUP, HEAD_DIM),
                       band_blocks(k), band_blocks(v), q_pos, k_pos, sinks)
    return o.reshape(B, T, ATTN_WIDTH), k[:, -WINDOW:], v[:, -WINDOW:]


def swa_sample(q, k, v, ck, cv, sinks):
    B, T = q.shape[:2]
    kf = jnp.concatenate([ck.astype(k.dtype), k], axis=1)
    vf = jnp.concatenate([cv.astype(v.dtype), v], axis=1)
    q_pos = (PAST_LEN + jnp.arange(T, dtype=jnp.int32))[None]
    k_pos = (PAST_LEN - WINDOW + jnp.arange(WINDOW + T, dtype=jnp.int32))[None]
    o = sink_attention(q[:, None], kf[:, None], vf[:, None], q_pos, k_pos, sinks)
    return o.reshape(B, T, ATTN_WIDTH), kf[:, -WINDOW:], vf[:, -WINDOW:]


def multi_scale_pool(ext, pos, w_pool, pool_scale):
    B = ext.shape[0]
    T = pos.shape[0]
    xf = ext.astype(jnp.float32)
    cs = jnp.concatenate([jnp.zeros_like(xf[:, :1]), jnp.cumsum(xf, axis=1)], axis=1)
    end = cs[:, POOL_STATE + 1:]
    cur = xf[:, POOL_STATE:]
    outs = []
    for g, w in enumerate(POOL_WINDOWS):
        sl = slice(g * POOL_GROUP_WIDTH, (g + 1) * POOL_GROUP_WIDTH)
        win_sum = end[..., sl] - cs[:, POOL_STATE + 1 - w:POOL_STATE + 1 - w + T, sl]
        cnt = jnp.minimum(pos + 1, w).astype(jnp.float32)[None, :, None]
        outs.append(win_sum / cnt - cur[..., sl])
    d = jnp.stack(outs, axis=2)
    y = jnp.einsum('btgc,gcd->btgd', d, w_pool.astype(jnp.float32)).reshape(B, T, POOL_WIDTH)
    return (y * pool_scale.astype(jnp.float32)).astype(ext.dtype)


def memory_kv(mem, g_mem, w_k, w_v, k_gain):
    B = mem.shape[0]
    hm = rms_norm(mem, g_mem)
    k = rms_norm((hm @ w_k).reshape(B, N_MEM, MEM_HEADS, MEM_HEAD_DIM), k_gain)
    v = (hm @ w_v).reshape(B, N_MEM, MEM_HEADS, MEM_HEAD_DIM)
    return k, v


def cross_attention(h, mk, mv, w_q, q_gain, w_o):
    B, T, _ = h.shape
    q = rms_norm((h @ w_q).reshape(B, T, MEM_HEADS, MEM_HEAD_DIM), q_gain)
    s = jnp.einsum('bthd,bmhd->bhtm', q.astype(jnp.float32), mk.astype(jnp.float32)) * (MEM_HEAD_DIM ** -0.5)
    p = jax.nn.softmax(s, axis=-1)
    o = jnp.einsum('bhtm,bmhd->bthd', p, mv.astype(jnp.float32)).reshape(B, T, MEM_WIDTH)
    return o.astype(h.dtype) @ w_o


def swiglu(h, w_gate, w_up, w_down):
    return (jax.nn.silu(h @ w_gate) * (h @ w_up)) @ w_down


def setup_inputs(seed: int = 0) -> dict:
    key = jax.random.key(seed)
    ks = jax.random.split(key, 32)

    def nrm(k, shape, scale=1.0):
        return jax.random.normal(k, shape, dtype=jnp.float32) * scale

    def gain(k, shape):
        return 1.0 + 0.02 * jax.random.normal(k, shape, dtype=jnp.float32)

    return {
        "x_prompt": nrm(ks[0], (BATCH, SEQ, D_MODEL)),
        "x_sample": nrm(ks[1], (DEC_BATCH, DEC_SEQ, D_MODEL)),
        "cache_attn_k": nrm(ks[2], (DEPTH, DEC_BATCH, WINDOW, N_KV_HEADS, HEAD_DIM)),
        "cache_attn_v": nrm(ks[3], (DEPTH, DEC_BATCH, WINDOW, N_KV_HEADS, HEAD_DIM)),
        "state_pool": nrm(ks[4], (DEPTH, DEC_BATCH, POOL_STATE, POOL_WIDTH)),
        "cache_mem_k": nrm(ks[5], (DEPTH, DEC_BATCH, N_MEM, MEM_HEADS, MEM_HEAD_DIM)),
        "cache_mem_v": nrm(ks[6], (DEPTH, DEC_BATCH, N_MEM, MEM_HEADS, MEM_HEAD_DIM)),
        "mem_prompt": nrm(ks[7], (BATCH, N_MEM, D_MODEL)),
        "g_mix": gain(ks[8], (DEPTH, D_MODEL)),
        "w_in": nrm(ks[9], (DEPTH, D_MODEL, IN_WIDTH), D_MODEL ** -0.5),
        "q_norm": gain(ks[10], (DEPTH, HEAD_DIM)),
        "k_norm": gain(ks[11], (DEPTH, HEAD_DIM)),
        "attn_sinks": nrm(ks[12], (DEPTH, N_HEADS), 0.5),
        "w_pool": nrm(ks[13], (DEPTH, N_POOL_GROUPS, POOL_GROUP_WIDTH, POOL_GROUP_WIDTH), POOL_GROUP_WIDTH ** -0.5),
        "pool_scale": gain(ks[14], (DEPTH, POOL_WIDTH)),
        "w_out": nrm(ks[15], (DEPTH, D_MODEL, D_MODEL), D_MODEL ** -0.5),
        "g_cross": gain(ks[16], (DEPTH, D_MODEL)),
        "g_mem": gain(ks[17], (DEPTH, D_MODEL)),
        "w_q_mem": nrm(ks[18], (DEPTH, D_MODEL, MEM_WIDTH), D_MODEL ** -0.5),
        "w_k_mem": nrm(ks[19], (DEPTH, D_MODEL, MEM_WIDTH), D_MODEL ** -0.5),
        "w_v_mem": nrm(ks[20], (DEPTH, D_MODEL, MEM_WIDTH), D_MODEL ** -0.5),
        "q_norm_mem": gain(ks[21], (DEPTH, MEM_HEAD_DIM)),
        "k_norm_mem": gain(ks[22], (DEPTH, MEM_HEAD_DIM)),
        "w_o_mem": nrm(ks[23], (DEPTH, MEM_WIDTH, D_MODEL), MEM_WIDTH ** -0.5),
        "g_ffn": gain(ks[24], (DEPTH, D_MODEL)),
        "w_gate": nrm(ks[25], (DEPTH, D_MODEL, D_FF), D_MODEL ** -0.5),
        "w_up": nrm(ks[26], (DEPTH, D_MODEL, D_FF), D_MODEL ** -0.5),
        "w_down": nrm(ks[27], (DEPTH, D_FF, D_MODEL), D_FF ** -0.5),
    }


def reference(x_prompt, x_sample, cache_attn_k, cache_attn_v, state_pool, cache_mem_k, cache_mem_v, mem_prompt,
              g_mix, w_in, q_norm, k_norm, attn_sinks, w_pool, pool_scale, w_out,
              g_cross, g_mem, w_q_mem, w_k_mem, w_v_mem, q_norm_mem, k_norm_mem, w_o_mem,
              g_ffn, w_gate, w_up, w_down):
    T_p = x_prompt.shape[1]
    T_s = x_sample.shape[1]
    pos_p = jnp.arange(T_p, dtype=jnp.int32)
    pos_s = PAST_LEN + jnp.arange(T_s, dtype=jnp.int32)
    xp, xs = x_prompt, x_sample
    ak_p, av_p, pl_p, mk_p, mv_p = [], [], [], [], []
    ak_s, av_s, pl_s = [], [], []
    for l in range(DEPTH):
        q, k, v, u = split_mixer_input(rms_norm(xp, g_mix[l]), w_in[l], q_norm[l], k_norm[l])
        a, nk, nv = swa_prompt(q, k, v, attn_sinks[l])
        ext = jnp.pad(u, ((0, 0), (POOL_STATE, 0), (0, 0)))
        pmix = multi_scale_pool(ext, pos_p, w_pool[l], pool_scale[l])
        xp = xp + jnp.concatenate([a, pmix], axis=-1) @ w_out[l]
        ak_p.append(nk); av_p.append(nv); pl_p.append(u[:, -POOL_STATE:])
        q, k, v, u = split_mixer_input(rms_norm(xs, g_mix[l]), w_in[l], q_norm[l], k_norm[l])
        a, nk, nv = swa_sample(q, k, v, cache_attn_k[l], cache_attn_v[l], attn_sinks[l])
        ext = jnp.concatenate([state_pool[l].astype(u.dtype), u], axis=1)
        pmix = multi_scale_pool(ext, pos_s, w_pool[l], pool_scale[l])
        xs = xs + jnp.concatenate([a, pmix], axis=-1) @ w_out[l]
        ak_s.append(nk); av_s.append(nv); pl_s.append(ext[:, -POOL_STATE:])
        mk, mv = memory_kv(mem_prompt, g_mem[l], w_k_mem[l], w_v_mem[l], k_norm_mem[l])
        mk_p.append(mk); mv_p.append(mv)
        xp = xp + cross_attention(rms_norm(xp, g_cross[l]), mk, mv, w_q_mem[l], q_norm_mem[l], w_o_mem[l])
        xs = xs + cross_attention(rms_norm(xs, g_cross[l]), cache_mem_k[l], cache_mem_v[l],
                                  w_q_mem[l], q_norm_mem[l], w_o_mem[l])
        xp = xp + swiglu(rms_norm(xp, g_ffn[l]), w_gate[l], w_up[l], w_down[l])
        xs = xs + swiglu(rms_norm(xs, g_ffn[l]), w_gate[l], w_up[l], w_down[l])
    return (xp, xs,
            jnp.stack(ak_p), jnp.stack(av_p), jnp.stack(pl_p), jnp.stack(mk_p), jnp.stack(mv_p),
            jnp.stack(ak_s), jnp.stack(av_s), jnp.stack(pl_s))
```

```cpp
#include <hip/hip_runtime.h>
#include <cstdio>
#include <cstdint>

#ifndef MK_SPLIT
#define MK_SPLIT 0
#endif

#ifndef PHASE_MASK
#define PHASE_MASK 0x3fff
#endif
#define PH_ON(k) (((PHASE_MASK) >> (k)) & 1)
#ifndef PROBE_DUP
#define PROBE_DUP -1
#endif
#define REP(k) for (int rep_ = 0; rep_ < ((PROBE_DUP == (k)) ? 2 : 1); ++rep_)
#define GAS __attribute__((address_space(1)))
#define LAS __attribute__((address_space(3)))
typedef unsigned short bf16_t;
typedef short bf16x8 __attribute__((ext_vector_type(8)));
typedef short s16x4 __attribute__((ext_vector_type(4)));
typedef float f32x4 __attribute__((ext_vector_type(4)));
typedef float f32x2 __attribute__((ext_vector_type(2)));
typedef unsigned u32x4 __attribute__((ext_vector_type(4)));
typedef unsigned u32x2 __attribute__((ext_vector_type(2)));

constexpr int DM = 4096, MP = 8192, MS = 512, M = MP + MS, NPAN = M / 256;
constexpr int INW = 4608, AW = 2048, KVW = 256, PW = 2048, NHEAD = 32;
constexpr int NMEM = 256, MW = 512, DFF = 11008, DEPTH = 2;
constexpr float EPS = 1e-6f;
constexpr float LOG2E = 1.4426950408889634f;
constexpr float QSCALE = 0.125f * LOG2E;
constexpr float QMSCALE = 0.08838834764831845f * LOG2E;

constexpr size_t O_Y = 0, O_AKP = 35651584, O_AVP = 35717120, O_PLP = 35782656, O_MKP = 35844096, O_MVP = 36106240,
                 O_AKS = 36368384, O_AVS = 36892672, O_PLS = 37416960, O_END = 37908480;

constexpr size_t MiB = 1u << 20;
constexpr size_t WS_CTL = 0, CTL_ZERO_BYTES = 320 * 1024;
constexpr size_t WS_SS = 64 * 1024;
constexpr int    SS_STRIDE = 8704;
constexpr size_t WS_SSM = WS_SS + 7 * 8704 * 4;
constexpr size_t WS_W = 2 * MiB;
constexpr size_t WL_IN = 0, WL_P = 36 * MiB, WL_OUT = 38 * MiB, WL_Q = 70 * MiB, WL_OM = 74 * MiB, WL_GU = 78 * MiB, WL_D = 250 * MiB, WL_SIZE = 336 * MiB;
constexpr size_t WS_WKV = WS_W + 2 * WL_SIZE;
constexpr size_t WS_XB = WS_WKV + 16 * MiB;
constexpr size_t WS_Q = WS_XB + 68 * MiB;
constexpr size_t WS_K = WS_Q + 34 * MiB;
constexpr size_t WS_V = WS_K + 5 * MiB;
constexpr size_t WS_U = WS_V + 5 * MiB;
constexpr size_t WS_WLOW = WS_U + 34 * MiB;
constexpr size_t WS_MIX = WS_WLOW + 34 * MiB;
constexpr size_t WS_QP = WS_MIX + 68 * MiB;
constexpr size_t WS_OM = WS_QP + 51 * MiB;
constexpr size_t WS_H = WS_OM + 9 * MiB;
constexpr size_t WS_MEMB = WS_H + 183 * MiB;
constexpr size_t WS_MEMRAW = WS_MEMB + 2 * MiB;
constexpr size_t WS_MKB = WS_MEMRAW + 2 * MiB;
constexpr size_t WS_MVB = WS_MKB + 1 * MiB;
constexpr size_t WS_MKS = WS_MVB + 1 * MiB;
constexpr size_t WS_MVS = WS_MKS + 4 * MiB;
constexpr size_t WS_CK = WS_MVS + 4 * MiB;
constexpr size_t WS_CV = WS_CK + 1 * MiB;
constexpr size_t WS_SLAB = WS_CV + 1 * MiB;
constexpr size_t WS_END = WS_SLAB + 64 * MiB;
constexpr size_t WS_DUMX = WS_END, WS_DUMXB = WS_DUMX + 136 * MiB, WS_DUMSS = WS_DUMXB + 68 * MiB;
constexpr int CW_BAR = 4096;
constexpr int CW_SP = 8192;
static_assert((CW_BAR + 3456) * 4 <= (int)WS_SS && WS_SS + 7 * 8704 * 4 + 256 * 4 <= CTL_ZERO_BYTES, "control region map");

constexpr int RING_BYTES = 131072, MISC_OFF = RING_BYTES + 8192, LDS_BYTES = 147456;

#define RLX_AGENT __ATOMIC_RELAXED, __HIP_MEMORY_SCOPE_AGENT
#define LDS_WAIT() asm volatile("s_waitcnt lgkmcnt(0)" ::: "memory")
#define VM_WAIT() asm volatile("s_waitcnt vmcnt(0)" ::: "memory")
__device__ __forceinline__ unsigned cvt_pk_bf16(float lo, float hi) { unsigned r; asm volatile("v_cvt_pk_bf16_f32 %0, %1, %2" : "=v"(r) : "v"(lo), "v"(hi)); return r; }
__device__ __forceinline__ float wave_sum(float v) {
#pragma unroll
    for (int o = 1; o < 64; o <<= 1) v += __shfl_xor(v, o);
    return v;
}
__device__ __forceinline__ float ex2(float x) { return __builtin_amdgcn_exp2f(x); }
__device__ __forceinline__ float rsq(float x) { return __builtin_amdgcn_rsqf(x); }

#define XB_TMO      128
#define XB_XCNT(j)  (256  + 64 * (j))
#define XB_XSUB(j)  (1280 + 64 * (j))
#define XB_XGEN(j)  (2304 + 64 * (j))
#define XB_TOP      3328
#define XB_TOPGEN   3392
#define XCD_BAR_WORDS 3456
#define XB_SPIN_CAP (1u << 20)
__device__ __forceinline__ unsigned xb_ld(unsigned* p)              { return __hip_atomic_load(p, __ATOMIC_RELAXED, __HIP_MEMORY_SCOPE_AGENT); }
__device__ __forceinline__ unsigned xb_add(unsigned* p, unsigned v) { return __hip_atomic_fetch_add(p, v, __ATOMIC_RELAXED, __HIP_MEMORY_SCOPE_AGENT); }
__device__ __forceinline__ unsigned xb_xcc_id() { return (unsigned)__builtin_amdgcn_s_getreg((3 << 11) | 20) & 0xFu; }
#define XB_SPIN(cond, bar) do { unsigned _sp = 0; while (cond) { __builtin_amdgcn_s_sleep(1); \
    if ((++_sp & 255u) == 0u) { if (xb_ld(&(bar)[XB_TMO])) break; if (_sp > XB_SPIN_CAP) { atomicAdd(&(bar)[XB_TMO], 1u); break; } } } } while (0)
struct XcdBarrier { unsigned* bar; unsigned x; volatile LAS unsigned* st; };
__device__ __forceinline__ XcdBarrier xcd_barrier_post(unsigned* bar, volatile LAS unsigned* st) {
    XcdBarrier b; b.bar = bar; b.x = xb_xcc_id(); b.st = st;
    if (threadIdx.x == 0) (void)xb_add(&bar[XB_XCNT(b.x)], 1u);
    return b;
}
__device__ __forceinline__ void xcd_barrier_complete(unsigned* bar, unsigned x, unsigned& nloc, unsigned& nx) {
    const unsigned G = gridDim.x * gridDim.y * gridDim.z;
    unsigned sum, cnt, mine, sp = 0u;
    for (;;) {
        sum = 0u; cnt = 0u; mine = 0u;
#pragma unroll
        for (unsigned j = 0; j < 16; ++j) { const unsigned c = xb_ld(&bar[XB_XCNT(j)]); sum += c; cnt += (c > 0u) ? 1u : 0u; mine = (j == x) ? c : mine; }
        if (sum == G) break;
        __builtin_amdgcn_s_sleep(1);
        if ((++sp & 255u) == 0u) { if (xb_ld(&bar[XB_TMO])) break; if (sp > XB_SPIN_CAP) { atomicAdd(&bar[XB_TMO], 1u); break; } }
    }
    nloc = mine > 0u ? mine : 1u; nx = cnt > 0u ? cnt : 1u;
}
__device__ __forceinline__ void xcd_barrier(const XcdBarrier& b) {
    asm volatile("s_waitcnt vmcnt(0)" ::: "memory");
    __syncthreads();
    if (threadIdx.x == 0) {
        unsigned* bar = b.bar;
        __builtin_amdgcn_s_waitcnt(0);
        unsigned nloc = b.st[0], nx = b.st[1];
        if (nloc == 0u) { xcd_barrier_complete(bar, b.x, nloc, nx); b.st[0] = nloc; b.st[1] = nx; }
        const unsigned old = xb_add(&bar[XB_XSUB(b.x)], 1u);
        const unsigned gen = old / nloc;
        if (old + 1u == (gen + 1u) * nloc) {
            __builtin_amdgcn_fence(__ATOMIC_RELEASE, "agent");
            asm volatile("s_waitcnt vmcnt(0)" ::: "memory");
            const unsigned og = xb_add(&bar[XB_TOP], 1u);
            const unsigned tg = og / nx;
            if (og + 1u == (tg + 1u) * nx) xb_add(&bar[XB_TOPGEN], 1u);
            else XB_SPIN(xb_ld(&bar[XB_TOPGEN]) == tg, bar);
            __builtin_amdgcn_fence(__ATOMIC_ACQUIRE, "agent");
            xb_add(&bar[XB_XGEN(b.x)], 1u);
            asm volatile("s_waitcnt vmcnt(0)" ::: "memory");
        } else {
            XB_SPIN(xb_ld(&bar[XB_XGEN(b.x)]) == gen, bar);
            __builtin_amdgcn_fence(__ATOMIC_ACQUIRE, "agent");
            asm volatile("s_waitcnt vmcnt(0)" ::: "memory");
        }
    }
    __syncthreads();
}

#define SP_WORDS 1088
#define SP_TOP   1024
__device__ __forceinline__ void sp_arrive(const XcdBarrier& b, unsigned* c) {
    asm volatile("s_waitcnt vmcnt(0)" ::: "memory");
    __syncthreads();
    if (threadIdx.x == 0) {
        __builtin_amdgcn_s_waitcnt(0);
        const unsigned nloc = b.st[0];
        const unsigned old = xb_add(&c[64 * b.x], 1u);
        if (old + 1u == nloc) {
            __builtin_amdgcn_fence(__ATOMIC_RELEASE, "agent");
            asm volatile("s_waitcnt vmcnt(0)" ::: "memory");
            xb_add(&c[SP_TOP], 1u);
        }
    }
}

__device__ __forceinline__ void sp_wait(const XcdBarrier& b, unsigned* c) {
    if (threadIdx.x == 0) { const unsigned nx = b.st[1]; XB_SPIN(xb_ld(&c[SP_TOP]) < nx, b.bar); __builtin_amdgcn_fence(__ATOMIC_ACQUIRE, "agent"); asm volatile("s_waitcnt vmcnt(0)" ::: "memory"); }
    __syncthreads();
}

namespace pg {
constexpr int BM = 256, BK = 64, HALF = 128, HTB = HALF * BK * 2, STAGE_BYTES = 8 * HTB, NXCD = 8, WGM = 8;
constexpr int SLAB_B = 131072;
__host__ __device__ __forceinline__ int lds_byte(int r, int c) { const int st = (r >> 4) * 2 + (c >> 5), rr = r & 15, cc = c & 31, ob = rr * 64 + cc * 2; return st * 1024 + (ob ^ (((ob >> 9) & 1) << 5)); }
__host__ __device__ __forceinline__ void stage_rc(int b, int& R, int& C) { const int st = b / 1024, sb = b % 1024, swz = sb ^ (((sb >> 9) & 1) << 5); R = (st >> 1) * 16 + swz / 64; C = (st & 1) * 32 + (swz % 64) / 2; }
__host__ __device__ __forceinline__ int perm32(int rho) { const int n = rho >> 4, i = rho & 15; return 8 * (i >> 2) + 4 * n + (i & 3); }

struct Unit { int pm, pn, kind, sp, uid; };
__device__ __forceinline__ int remap(int L, int nwg) { const int q = nwg / NXCD, r = nwg % NXCD, xcd = L % NXCD, off = L / NXCD; return (xcd < r ? xcd * (q + 1) : r * (q + 1) + (xcd - r) * q) + off; }
__device__ __forceinline__ void tile_from_wgid(int wgid, int nM, int nN, int& pm, int& pn) {
    const int nig = WGM * nN, gid = wgid / nig, fm = gid * WGM, gsz = (nM - fm) < WGM ? (nM - fm) : WGM;
    pm = fm + ((wgid % nig) % gsz); pn = (wgid % nig) / gsz;
}

struct DescPlain {
    static constexpr bool SPLIT = false, HANDOFF = false; static constexpr int S = 1;
    const bf16_t* A; const bf16_t* B; int lda, ldb, nN, ntile;
    __device__ __forceinline__ int total() const { return NPAN * nN; }
    __device__ __forceinline__ void decode(int L, Unit& u) const { tile_from_wgid(remap(L, NPAN * nN), NPAN, nN, u.pm, u.pn); u.kind = 0; u.sp = -1; u.uid = 0; }
    __device__ __forceinline__ const char* a_ptr(const Unit& u) const { return (const char*)(A + (size_t)u.pm * 256 * lda); }
    __device__ __forceinline__ const char* b_ptr(const Unit& u) const { return (const char*)(B + (size_t)u.pn * 256 * ldb); }
    __device__ __forceinline__ int nt(const Unit&) const { return ntile; }
};
template <int LDA, int LDB, int NN, int NT, int PFULL, int S_>
struct DescTail {
    static constexpr bool SPLIT = true, HANDOFF = true; static constexpr int S = S_, lda = LDA, ldb = LDB, NLEFT = (NPAN - PFULL) * NN;
    const bf16_t* A; const bf16_t* B; const bf16_t* Am; const bf16_t* Bm; int nmem; unsigned char* slab;
    unsigned* wtop = nullptr; unsigned wnx = 0;
    __device__ __forceinline__ bool need_wait(const Unit& u) const { return wtop != nullptr && u.sp >= 0; }
    __device__ __forceinline__ void unit_of(int uid, Unit& u) const { u.sp = -1; u.uid = uid; u.pm = PFULL + uid / NN; u.pn = uid % NN; u.kind = 0; }
    __device__ __forceinline__ int nfull() const { return PFULL * NN + nmem; }
    __device__ __forceinline__ int total() const { return PFULL * NN + nmem + NLEFT * S; }
    __device__ __forceinline__ void decode(int L, Unit& u) const { const int nf = nfull();
        if (L < nf) { const int w = remap(L, nf); u.sp = -1; u.uid = 0;
            if (w < PFULL * NN) { tile_from_wgid(w, PFULL, NN, u.pm, u.pn); u.kind = 0; } else { u.pm = 0; u.pn = w - PFULL * NN; u.kind = 1; } }
        else { const int j = L - nf; u.sp = j % S; u.uid = j / S; u.pm = PFULL + u.uid / NN; u.pn = u.uid % NN; u.kind = 0; } }
    __device__ __forceinline__ static int kt0(int s) { constexpr int e = NT / 2, b = e / S, r = e % S; return s < 0 ? 0 : 2 * (s * b + (s < r ? s : r)); }
    __device__ __forceinline__ int nt(const Unit& u) const { constexpr int e = NT / 2, b = e / S, r = e % S; return u.sp < 0 ? NT : 2 * (b + (u.sp < r ? 1 : 0)); }
    __device__ __forceinline__ const char* a_ptr(const Unit& u) const { return u.kind ? (const char*)Am : (const char*)(A + (size_t)u.pm * 256 * LDA + kt0(u.sp) * 64); }
    __device__ __forceinline__ const char* b_ptr(const Unit& u) const { return (const char*)((u.kind ? Bm : B) + (size_t)u.pn * 256 * LDB + kt0(u.sp) * 64); }
};
struct DescGU {
    static constexpr bool SPLIT = true, HANDOFF = false; static constexpr int S = 2, lda = 4096, ldb = 4096, NLEFT = 108, NFULL = 2816, NN = 86;
    const bf16_t* A; const bf16_t* B; unsigned char* slab;
    __device__ __forceinline__ void unit_of(int uid, Unit& u) const { u.sp = -1; u.uid = uid; u.pm = 32 + (uid & 1); u.pn = 32 + (uid >> 1); u.kind = 0; }
    __device__ __forceinline__ int total() const { return NFULL + NLEFT * S; }
    __device__ __forceinline__ void decode(int L, Unit& u) const {
        if (L < NFULL) { tile_from_wgid(remap(L, NFULL), NPAN, NN, u.pm, u.pn); u.kind = 0; u.sp = -1; u.uid = 0; }
        else { const int j = L - NFULL; unit_of(j >> 1, u); u.sp = j & 1; } }
    __device__ __forceinline__ int nt(const Unit& u) const { return u.sp < 0 ? 64 : 32; }
    __device__ __forceinline__ const char* a_ptr(const Unit& u) const { return (const char*)(A + (size_t)u.pm * 256 * 4096 + (u.sp > 0 ? 2048 : 0)); }
    __device__ __forceinline__ const char* b_ptr(const Unit& u) const { return (const char*)(B + (size_t)u.pn * 256 * 4096 + (u.sp > 0 ? 2048 : 0)); }
};
struct DescFold {
    static constexpr bool SPLIT = false, HANDOFF = false; static constexpr int S = 1;
    const bf16_t* A; const bf16_t* B; int lda, ldb;
    __device__ __forceinline__ int total() const { return 256; }
    __device__ __forceinline__ void decode(int L, Unit& u) const { u.kind = L >> 5; u.pm = (L >> 1) & 15; u.pn = L & 1; u.sp = -1; u.uid = 0; }
    __device__ __forceinline__ const char* a_ptr(const Unit& u) const { return (const char*)(A + (size_t)(u.kind >> 2) * DM * 2048 + (size_t)u.pm * 256 * 2048 + (u.kind & 3) * 512); }
    __device__ __forceinline__ const char* b_ptr(const Unit& u) const { return (const char*)B + (size_t)(u.kind >> 2) * WL_SIZE + ((size_t)(u.kind & 3) * 512 * 512 + (size_t)u.pn * 256 * 512) * 2; }
    __device__ __forceinline__ int nt(const Unit&) const { return 8; }
};
struct DescSplitK {
    static constexpr bool SPLIT = false, HANDOFF = false; static constexpr int S = 1;
    const bf16_t* A; const bf16_t* B; int lda, ldb;
    __device__ __forceinline__ int total() const { return NPAN * 6; }
    __device__ __forceinline__ void decode(int L, Unit& u) const { tile_from_wgid(remap(L, NPAN * 6), NPAN, 6, u.pm, u.pn); u.kind = 0; u.sp = -1; u.uid = 0; }
    __device__ __forceinline__ const char* a_ptr(const Unit& u) const { return (const char*)(A + (size_t)u.pm * 256 * 4096 + (u.pn >> 1) * 1408); }
    __device__ __forceinline__ const char* b_ptr(const Unit& u) const { return (const char*)(B + (size_t)(u.pn & 1) * 256 * 4096 + (u.pn >> 1) * 1408); }
    __device__ __forceinline__ int nt(const Unit& u) const { return (u.pn >> 1) < 2 ? 22 : 20; }
};


struct EpiInProj {
    static constexpr bool PERM = true;
    const float* __restrict__ ss; const float* __restrict__ ssm; const float* __restrict__ qg; const float* __restrict__ kg;
    bf16_t *Q, *K, *V, *U; float* memraw;
    float *akp, *avp, *plp, *aks, *avs, *pls;
    struct Pre { float ssv; };
    __device__ __forceinline__ Pre pre_load(const Unit& u, int ai, int m, int wr, int wc, int fr, int fq) const { const int rl = ai * HALF + wr * 64 + m * 16 + fr; Pre p; p.ssv = (u.kind == 1) ? ssm[rl] : ss[u.pm * BM + rl]; return p; }
    __device__ __forceinline__ void rowgroup(const f32x4 (&a)[2][2], const Pre& pre, const Unit& u, int ai, int m, int wr, int wc, int fr, int fq) const {
        const int rl = ai * HALF + wr * 64 + m * 16 + fr;
        if (u.kind == 1) {
            float* dst = memraw + (size_t)(u.pn >> 2) * 256 * 1024 + (size_t)rl * 1024 + (u.pn & 3) * 256 + wc * 64 + 8 * fq;
            const float rs = rsq(pre.ssv * (1.0f / 4096.0f) + EPS);
#pragma unroll
            for (int bj = 0; bj < 2; ++bj)
#pragma unroll
                for (int n = 0; n < 2; ++n) *(f32x4*)(dst + 32 * bj + 4 * n) = a[bj][n] * rs;
            return;
        }
        const int pn = u.pn;
        const bool normed = pn < 9;
        bf16_t* dst; int ld, cb; float* fo_p = nullptr; float* fo_s = nullptr; int fo_kind = 0;
        if (pn < 8) { dst = Q; ld = 2048; cb = pn * 256; }
        else if (pn == 8) { dst = K; ld = 256; cb = 0; fo_p = akp; fo_s = aks; fo_kind = 1; }
        else if (pn == 9) { dst = V; ld = 256; cb = 0; fo_p = avp; fo_s = avs; fo_kind = 1; }
        else { dst = U; ld = 2048; cb = (pn - 10) * 256; fo_p = plp; fo_s = pls; fo_kind = 2; }
        const int colw = cb + wc * 64 + 8 * fq;
        const bool fout = (fo_kind != 0) && (u.pm >= 31);
        const int row = u.pm * BM + rl;
        const float rs = rsq(pre.ssv * (1.0f / 4096.0f) + EPS);
        f32x4 v[2][2];
#pragma unroll
        for (int bj = 0; bj < 2; ++bj)
#pragma unroll
            for (int n = 0; n < 2; ++n) v[bj][n] = a[bj][n] * rs;
        if (normed) {
            const float* gp = (pn < 8) ? qg : kg;
            float s = 0.f;
#pragma unroll
            for (int bj = 0; bj < 2; ++bj)
#pragma unroll
                for (int n = 0; n < 2; ++n) { const f32x4 x = v[bj][n]; s += (x[0] * x[0] + x[1] * x[1]) + (x[2] * x[2] + x[3] * x[3]); }
            s += __shfl_xor(s, 16); s += __shfl_xor(s, 32);
            float hs = rsq(s * (1.0f / 64.0f) + EPS); if (pn < 8) hs *= QSCALE;
#pragma unroll
            for (int bj = 0; bj < 2; ++bj)
#pragma unroll
                for (int n = 0; n < 2; ++n) v[bj][n] = v[bj][n] * hs * *(const f32x4*)(gp + 32 * bj + 8 * fq + 4 * n);
        }
        bf16_t* rowp = dst + (size_t)row * ld + colw;
#pragma unroll
        for (int bj = 0; bj < 2; ++bj) { u32x4 w; w.x = cvt_pk_bf16(v[bj][0][0], v[bj][0][1]); w.y = cvt_pk_bf16(v[bj][0][2], v[bj][0][3]); w.z = cvt_pk_bf16(v[bj][1][0], v[bj][1][1]); w.w = cvt_pk_bf16(v[bj][1][2], v[bj][1][3]);
            *(u32x4*)(rowp + 32 * bj) = w; }
        if (fout) {
            float* fp = nullptr;
            if (fo_kind == 1) {
                if (row < MP) { if (row >= MP - 128) fp = fo_p + (size_t)(row - (MP - 128)) * 256; }
                else { const int sr = row - MP; fp = fo_s + (size_t)((sr >> 6) * 128 + 64 + (sr & 63)) * 256; }
            } else {
                if (row < MP) { if (row >= MP - 15) fp = fo_p + (size_t)(row - (MP - 15)) * 2048; }
                else { const int sr = row - MP, t = sr & 63; if (t >= 49) fp = fo_s + (size_t)((sr >> 6) * 15 + (t - 49)) * 2048; }
            }
            if (fp) { fp += colw;
#pragma unroll
                for (int bj = 0; bj < 2; ++bj)
#pragma unroll
                    for (int n = 0; n < 2; ++n) *(f32x4*)(fp + 32 * bj + 4 * n) = v[bj][n]; }
        }
    }
};

struct EpiFold {
    static constexpr bool PERM = true;
    unsigned char* wbase;
    struct Pre {}; __device__ __forceinline__ Pre pre_load(const Unit&, int, int, int, int, int, int) const { return Pre{}; }
    __device__ __forceinline__ void rowgroup(const f32x4 (&a)[2][2], const Pre& pre, const Unit& u, int ai, int m, int wr, int wc, int fr, int fq) const {
        bf16_t* rowp = (bf16_t*)(wbase + (size_t)(u.kind >> 2) * WL_SIZE) + (size_t)(u.pm * BM + ai * HALF + wr * 64 + m * 16 + fr) * DM + 2048 + (u.kind & 3) * 512 + u.pn * BM + wc * 32 + 8 * fq;
#pragma unroll
        for (int bj = 0; bj < 2; ++bj) { const f32x4 v0 = a[bj][0], v1 = a[bj][1];
            u32x4 w; w.x = cvt_pk_bf16(v0[0], v0[1]); w.y = cvt_pk_bf16(v0[2], v0[3]); w.z = cvt_pk_bf16(v1[0], v1[1]); w.w = cvt_pk_bf16(v1[2], v1[3]);
            *(u32x4*)(rowp + bj * HALF) = w; }
    }
};

struct EpiResid {
    static constexpr bool PERM = true;
    bf16_t* xb; float* ss_out; float* yout;
    struct Pre { u32x4 x[2]; };
    __device__ __forceinline__ Pre pre_load(const Unit& u, int ai, int m, int wr, int wc, int fr, int fq) const {
        const bf16_t* xr = xb + (size_t)(u.pm * BM + ai * HALF + wr * 64 + m * 16 + fr) * DM + u.pn * BM + wc * 32 + 8 * fq; Pre p;
#pragma unroll
        for (int bj = 0; bj < 2; ++bj) p.x[bj] = *(const u32x4*)(xr + bj * HALF);
        return p;
    }
    __device__ __forceinline__ void rowgroup(const f32x4 (&a)[2][2], const Pre& pre, const Unit& u, int ai, int m, int wr, int wc, int fr, int fq) const {
        const int rl = ai * HALF + wr * 64 + m * 16 + fr; const size_t orow = (size_t)(u.pm * BM + rl) * DM + u.pn * BM + wc * 32 + 8 * fq;
        float s = 0.f;
#pragma unroll
        for (int bj = 0; bj < 2; ++bj) { const u32x4 xo = pre.x[bj];
            const f32x4 x0 = (f32x4){__uint_as_float(xo.x << 16), __uint_as_float(xo.x & 0xffff0000u), __uint_as_float(xo.y << 16), __uint_as_float(xo.y & 0xffff0000u)} + a[bj][0];
            const f32x4 x1 = (f32x4){__uint_as_float(xo.z << 16), __uint_as_float(xo.z & 0xffff0000u), __uint_as_float(xo.w << 16), __uint_as_float(xo.w & 0xffff0000u)} + a[bj][1];
            if (yout) { *(f32x4*)(yout + orow + bj * HALF) = x0; *(f32x4*)(yout + orow + bj * HALF + 4) = x1; }
            else { u32x4 w; w.x = cvt_pk_bf16(x0[0], x0[1]); w.y = cvt_pk_bf16(x0[2], x0[3]); w.z = cvt_pk_bf16(x1[0], x1[1]); w.w = cvt_pk_bf16(x1[2], x1[3]); *(u32x4*)(xb + orow + bj * HALF) = w;
#pragma unroll
                for (int e = 0; e < 4; ++e) { const float lo = __uint_as_float(w[e] << 16), hi = __uint_as_float(w[e] & 0xffff0000u); s += lo * lo + hi * hi; } } }
        if (!yout) { s += __shfl_xor(s, 16); s += __shfl_xor(s, 32); if (fq == 0) atomicAdd(ss_out + u.pm * BM + rl, s); }
    }
};

struct EpiF32Part {
    static constexpr bool IDEMP = true; static constexpr bool PERM = true;
    bf16_t* C;
    struct Pre {}; __device__ __forceinline__ Pre pre_load(const Unit&, int, int, int, int, int, int) const { return Pre{}; }
    __device__ __forceinline__ void rowgroup(const f32x4 (&a)[2][2], const Pre& pre, const Unit& u, int ai, int m, int wr, int wc, int fr, int fq) const {
        bf16_t* rowp = C + (size_t)(u.pn >> 1) * M * 512 + (u.pn & 1) * BM + wc * 32 + 8 * fq + (size_t)(u.pm * BM + ai * HALF + wr * 64 + m * 16 + fr) * 512;
#pragma unroll
        for (int bj = 0; bj < 2; ++bj) { u32x4 w; w.x = cvt_pk_bf16(a[bj][0][0], a[bj][0][1]); w.y = cvt_pk_bf16(a[bj][0][2], a[bj][0][3]); w.z = cvt_pk_bf16(a[bj][1][0], a[bj][1][1]); w.w = cvt_pk_bf16(a[bj][1][2], a[bj][1][3]);
            *(u32x4*)(rowp + bj * HALF) = w; }
    }
};

struct EpiSwiGLU {
    static constexpr bool PERM = true;
    const float* __restrict__ ss; bf16_t* H;
    struct Pre { float ssv; };
    __device__ __forceinline__ Pre pre_load(const Unit& u, int ai, int m, int wr, int wc, int fr, int fq) const { Pre p; p.ssv = ss[u.pm * BM + ai * HALF + wr * 64 + m * 16 + fr]; return p; }
    __device__ __forceinline__ void rowgroup(const f32x4 (&a)[2][2], const Pre& pre, const Unit& u, int ai, int m, int wr, int wc, int fr, int fq) const {
        const int row = u.pm * BM + ai * HALF + wr * 64 + m * 16 + fr;
        const float rs = rsq(pre.ssv * (1.0f / 4096.0f) + EPS);
        float h[8];
#pragma unroll
        for (int n = 0; n < 2; ++n)
#pragma unroll
            for (int i = 0; i < 4; ++i) { const float g = a[0][n][i] * rs, uu = a[1][n][i] * rs;
                h[n * 4 + i] = g * uu * __builtin_amdgcn_rcpf(1.0f + ex2(-g * LOG2E)); }
        u32x4 w; w.x = cvt_pk_bf16(h[0], h[1]); w.y = cvt_pk_bf16(h[2], h[3]); w.z = cvt_pk_bf16(h[4], h[5]); w.w = cvt_pk_bf16(h[6], h[7]);
        *(u32x4*)(H + (size_t)row * DFF + u.pn * 128 + wc * 32 + 8 * fq) = w;
    }
};

template <class Desc, class Epi, bool ALIGN_EPI>
__device__ __forceinline__ void gemm_phase(LAS unsigned char* lds, const Desc& D, const Epi& E, int G, int c) {
    int tid = threadIdx.x; asm volatile("" : "+v"(tid));
    const int wid = __builtin_amdgcn_readfirstlane(tid >> 6), lane = tid & 63, wr = wid >> 2, wc = wid & 3, fr = lane & 15, fq = lane >> 4;
    unsigned voffA[2], voffB[2];
#pragma unroll
    for (int i = 0; i < 2; ++i) { int R, C; stage_rc(tid * 16 + i * 8192, R, C); const int Rb = Epi::PERM ? ((R & ~31) + perm32(R & 31)) : R;
        voffA[i] = (unsigned)(R * D.lda + C) * 2u; voffB[i] = (unsigned)(Rb * D.ldb + C) * 2u; }
    const size_t kstep = (size_t)(BK * 2);
    const size_t hstepA = (size_t)HALF * D.lda * 2, hstepB = (size_t)HALF * D.ldb * 2;
    const unsigned ldsw = (unsigned)wid * 1024u;
    const int aoff = lds_byte(wr * 64 + fr, fq * 8), boff = lds_byte(wc * 32 + fr, fq * 8);
    const LAS unsigned char* pA = lds + aoff; const LAS unsigned char* pB = lds + 4 * HTB + boff;
    asm volatile("" : "+v"(pA), "+v"(pB));
#define PG8_SA(b, h) (((b) * 2 + (h)) * HTB)
#define PG8_SB(b, h) ((4 + (b) * 2 + (h)) * HTB)
#define PG8_STAGE(bufoff, gbase, voff) do { _Pragma("unroll") for (int _i = 0; _i < 2; ++_i) \
        __builtin_amdgcn_global_load_lds((const unsigned*)((const char*)(gbase) + (voff)[_i]), (LAS unsigned*)(lds + (bufoff) + ldsw + _i * 8192), 16, 0, 0); } while (0)
#define PG8_LDA(dst, b, h) do { _Pragma("unroll") for (int m = 0; m < 4; ++m) _Pragma("unroll") for (int k = 0; k < 2; ++k) dst[m][k] = *(const LAS bf16x8*)(pA + PG8_SA(b, h) + m * 2048 + k * 1024); } while (0)
#define PG8_LDB(dst, b, h) do { _Pragma("unroll") for (int n = 0; n < 2; ++n) _Pragma("unroll") for (int k = 0; k < 2; ++k) dst[n][k] = *(const LAS bf16x8*)(pB + (PG8_SB(b, h) - 4 * HTB) + n * 2048 + k * 1024); } while (0)
#define PG8_MMA(ai, bj, At, Bt) do { __builtin_amdgcn_s_setprio(1); _Pragma("unroll") for (int m = 0; m < 4; ++m) _Pragma("unroll") for (int n = 0; n < 2; ++n) _Pragma("unroll") for (int k = 0; k < 2; ++k) \
        acc[ai][bj][m][n] = __builtin_amdgcn_mfma_f32_16x16x32_bf16(Bt[n][k], At[m][k], acc[ai][bj][m][n], 0, 0, 0); __builtin_amdgcn_s_setprio(0); } while (0)
#define PG8_WAIT_V(n) asm volatile("s_waitcnt vmcnt(" #n ")" ::: "memory")
#define PG8_WAIT_L(n) asm volatile("s_waitcnt lgkmcnt(" #n ")" ::: "memory")
#define PG8_BAR __builtin_amdgcn_s_barrier()
#define PG8_SCHED __builtin_amdgcn_sched_barrier(0)
    const int total = D.total();
    Unit cur, nxt; int ui = 0;
    if (c >= total) return;
    D.decode(c, cur);
    f32x4 acc[2][2][4][2];
#pragma unroll
    for (int a = 0; a < 2; ++a)
#pragma unroll
        for (int b = 0; b < 2; ++b)
#pragma unroll
            for (int m = 0; m < 4; ++m)
#pragma unroll
                for (int n = 0; n < 2; ++n) acc[a][b][m][n] = (f32x4){0.f, 0.f, 0.f, 0.f};
    bf16x8 At[4][2], B0[2][2], B1[2][2];
    const char* cA = D.a_ptr(cur); const char* cB = D.b_ptr(cur);
    int nt = D.nt(cur);
    bool acq = false;
#define PG8_AWAIT(u_) do { if constexpr (Desc::HANDOFF) { if (D.need_wait(u_) && !acq) { acq = true; \
        if (wid == 0) { unsigned sp_ = 0; \
            while ((unsigned)__builtin_amdgcn_readfirstlane((int)__hip_atomic_load(D.wtop, __ATOMIC_RELAXED, __HIP_MEMORY_SCOPE_AGENT)) < D.wnx) { __builtin_amdgcn_s_sleep(2); if (++sp_ > (1u << 22)) break; } \
            __builtin_amdgcn_fence(__ATOMIC_ACQUIRE, "agent"); asm volatile("s_waitcnt vmcnt(0)" ::: "memory"); } \
        asm volatile("" ::: "memory"); PG8_BAR; asm volatile("" ::: "memory"); } } } while (0)
    PG8_AWAIT(cur);
    PG8_STAGE(PG8_SB(0, 0), cB, voffB); PG8_STAGE(PG8_SB(0, 1), cB + hstepB, voffB); PG8_STAGE(PG8_SA(0, 0), cA, voffA); PG8_STAGE(PG8_SA(0, 1), cA + hstepA, voffA);
    if (wr == 1) PG8_BAR;
    PG8_WAIT_V(2); PG8_BAR;
    PG8_STAGE(PG8_SB(1, 0), cB + kstep, voffB); PG8_STAGE(PG8_SA(1, 0), cA + kstep, voffA); PG8_STAGE(PG8_SB(1, 1), cB + hstepB + kstep, voffB);
    PG8_WAIT_V(6); PG8_BAR;
    for (;;) {
        const int Ln = (ui + 1) * G + c; const bool has_next = Ln < total;
        if (has_next) D.decode(Ln, nxt);
        const char* nA = has_next ? D.a_ptr(nxt) : cA; const char* nB = has_next ? D.b_ptr(nxt) : cB;
        for (int t = 0; t < nt; t += 2) {
            const bool last = (t == nt - 2);
            if (last && has_next) PG8_AWAIT(nxt);
            const char* a1 = cA + (size_t)(t + 1) * kstep;
            const char* a2 = last ? nA : cA + (size_t)(t + 2) * kstep; const char* b2 = last ? nB : cB + (size_t)(t + 2) * kstep;
            const char* a3 = a2 + kstep; const char* b3 = b2 + kstep;
            PG8_LDB(B0, 0, 0); PG8_LDB(B1, 0, 1); PG8_SCHED; PG8_LDA(At, 0, 0); PG8_STAGE(PG8_SA(1, 1), a1 + hstepA, voffA);
            PG8_WAIT_V(8); PG8_WAIT_L(0); PG8_BAR; PG8_MMA(0, 0, At, B0); PG8_MMA(0, 1, At, B1); PG8_BAR; PG8_SCHED;
            PG8_LDA(At, 0, 1); PG8_STAGE(PG8_SB(0, 0), b2, voffB); PG8_STAGE(PG8_SB(0, 1), b2 + hstepB, voffB); PG8_STAGE(PG8_SA(0, 0), a2, voffA);
            PG8_WAIT_V(8); PG8_WAIT_L(0); PG8_BAR; PG8_MMA(1, 0, At, B0); PG8_MMA(1, 1, At, B1); PG8_BAR; PG8_SCHED;
            PG8_LDB(B0, 1, 0); PG8_LDB(B1, 1, 1); PG8_SCHED; PG8_LDA(At, 1, 0); PG8_STAGE(PG8_SA(0, 1), a2 + hstepA, voffA);
            PG8_WAIT_V(8); PG8_WAIT_L(0); PG8_BAR; PG8_MMA(0, 0, At, B0); PG8_MMA(0, 1, At, B1); PG8_BAR; PG8_SCHED;
            PG8_LDA(At, 1, 1); PG8_STAGE(PG8_SB(1, 0), b3, voffB); PG8_STAGE(PG8_SB(1, 1), b3 + hstepB, voffB); PG8_STAGE(PG8_SA(1, 0), a3, voffA);
            PG8_WAIT_V(8); PG8_WAIT_L(0); PG8_BAR; PG8_MMA(1, 0, At, B0); PG8_MMA(1, 1, At, B1); PG8_BAR; PG8_SCHED;
        }
        if constexpr (ALIGN_EPI) { if (wr == 0) PG8_BAR; }
        { int fr_ = fr, fq_ = fq, wr_ = wr, wc_ = wc, ln_ = lane; asm volatile("" : "+v"(fr_), "+v"(fq_), "+v"(ln_)); asm volatile("" : "+s"(wr_), "+s"(wc_));
          bool slabbed = false;
          if constexpr (Desc::SPLIT) {
              if (cur.sp >= 0) {
                  const __amdgpu_buffer_rsrc_t rs = __builtin_amdgcn_make_buffer_rsrc((void*)(D.slab + (size_t)(cur.uid * Desc::S + cur.sp) * SLAB_B), (short)0, SLAB_B, 0x00020000);
                  const int loff = ((wr_ * 4 + wc_) * 16 * 64 + ln_) * 16;
#pragma unroll
                  for (int rp = 0; rp < 16; ++rp) { const f32x4 a0 = acc[rp >> 3][(rp >> 2) & 1][rp & 3][0], a1 = acc[rp >> 3][(rp >> 2) & 1][rp & 3][1];
                      u32x4 w; w.x = cvt_pk_bf16(a0[0], a0[1]); w.y = cvt_pk_bf16(a0[2], a0[3]); w.z = cvt_pk_bf16(a1[0], a1[1]); w.w = cvt_pk_bf16(a1[2], a1[3]);
                      __builtin_amdgcn_raw_buffer_store_b128(w, rs, loff, rp * 1024, 0); }
                  slabbed = true;
              }
          }
          if (!slabbed) {
              typename Epi::Pre pre[2][4];
#pragma unroll
              for (int ai = 0; ai < 2; ++ai)
#pragma unroll
                  for (int m = 0; m < 4; ++m) pre[ai][m] = E.pre_load(cur, ai, m, wr_, wc_, fr_, fq_);
#pragma unroll
              for (int ai = 0; ai < 2; ++ai)
#pragma unroll
                  for (int m = 0; m < 4; ++m) { const f32x4 v[2][2] = {{acc[ai][0][m][0], acc[ai][0][m][1]}, {acc[ai][1][m][0], acc[ai][1][m][1]}}; E.rowgroup(v, pre[ai][m], cur, ai, m, wr_, wc_, fr_, fq_); }
          } }
        if (!has_next) break;
#pragma unroll
        for (int a = 0; a < 2; ++a)
#pragma unroll
            for (int b = 0; b < 2; ++b)
#pragma unroll
                for (int m = 0; m < 4; ++m)
#pragma unroll
                    for (int n = 0; n < 2; ++n) acc[a][b][m][n] = (f32x4){0.f, 0.f, 0.f, 0.f};
        cur = nxt; cA = nA; cB = nB; ++ui; nt = D.nt(cur);
        if constexpr (ALIGN_EPI) { if (wr == 1) PG8_BAR; }
    }
    PG8_WAIT_V(0);
    if constexpr (!ALIGN_EPI) { if (wr == 0) PG8_BAR; }
    PG8_BAR;
#undef PG8_SA
#undef PG8_SB
#undef PG8_STAGE
#undef PG8_LDA
#undef PG8_LDB
#undef PG8_MMA
#undef PG8_WAIT_V
#undef PG8_WAIT_L
#undef PG8_BAR
#undef PG8_SCHED
#undef PG8_AWAIT
}
template <class Desc, class Epi>
__device__ __forceinline__ void reduce_pass(const Desc& D, const Epi& E, int vcu, int G, int wave, int lane) {
    constexpr int S = Desc::S, NT = Desc::NLEFT * 64, TB = (S >= 4) ? 1 : 2;
    const int gw = vcu * 8 + wave, NGW = G * 8, fr = lane & 15, fq = lane >> 4;
    for (int task0 = gw; task0 < NT; task0 += NGW * TB) {
        u32x4 x[TB][2][S]; typename Epi::Pre pre[TB]; Unit u[TB]; int tk[TB];
#pragma unroll
        for (int t = 0; t < TB; ++t) { const int task = task0 + t * NGW; tk[t] = task;
            if (task < NT) { const int uid = task >> 6, w = (task >> 3) & 7, ai = (task >> 2) & 1, m = task & 3;
                D.unit_of(uid, u[t]);
                const unsigned char* base = D.slab + (size_t)uid * S * SLAB_B + (size_t)(((w * 16 + ai * 8 + m) * 64 + lane) * 16);
#pragma unroll
                for (int bj = 0; bj < 2; ++bj)
#pragma unroll
                    for (int sI = 0; sI < S; ++sI) x[t][bj][sI] = *(const u32x4*)(base + (size_t)sI * SLAB_B + bj * 4096);
                pre[t] = E.pre_load(u[t], ai, m, w >> 2, w & 3, fr, fq); } }
#pragma unroll
        for (int t = 0; t < TB; ++t) { const int task = tk[t];
            if (task < NT) { const int w = (task >> 3) & 7, ai = (task >> 2) & 1, m = task & 3;
                f32x4 v[2][2];
#pragma unroll
                for (int bj = 0; bj < 2; ++bj) { f32x4 s0 = (f32x4){0.f, 0.f, 0.f, 0.f}, s1 = s0;
#pragma unroll
                    for (int sI = 0; sI < S; ++sI) { const u32x4 y = x[t][bj][sI];
                        s0 += (f32x4){__uint_as_float(y.x << 16), __uint_as_float(y.x & 0xffff0000u), __uint_as_float(y.y << 16), __uint_as_float(y.y & 0xffff0000u)};
                        s1 += (f32x4){__uint_as_float(y.z << 16), __uint_as_float(y.z & 0xffff0000u), __uint_as_float(y.w << 16), __uint_as_float(y.w & 0xffff0000u)}; }
                    v[bj][0] = s0; v[bj][1] = s1; }
                E.rowgroup(v, pre[t], u[t], ai, m, w >> 2, w & 3, fr, fq); } }
    }
}
}

template <int MODE>
__device__ __forceinline__ void transpose_item(const float* W, int K, int N, bf16_t* WT, const float* kscale, const float* nscale, int col_off, LAS unsigned char* scr, int item, int lane, int ldt = 0) {
    const int nblk = N / 64, kb = item / nblk, nb = item % nblk, k0 = 64 * kb, n0 = 64 * nb;
    const int r16 = lane & 15, q = lane >> 4;
    const float* src = W + (size_t)(k0 + 2 * q) * N + n0 + 4 * r16;
    f32x4 v[16];
#pragma unroll
    for (int j = 0; j < 16; ++j) v[j] = *(const f32x4*)(src + (size_t)(8 * (j >> 1) + (j & 1)) * N);
    if (nscale) { const f32x4 ns = *(const f32x4*)(nscale + n0 + 4 * r16);
#pragma unroll
        for (int j = 0; j < 16; ++j) v[j] = v[j] * ns; }
    if (kscale) {
#pragma unroll
        for (int i = 0; i < 8; ++i) { const f32x2 g = *(const f32x2*)(kscale + k0 + 8 * i + 2 * q); v[2 * i] = v[2 * i] * g[0]; v[2 * i + 1] = v[2 * i + 1] * g[1]; } }
#pragma unroll
    for (int i = 0; i < 8; ++i)
#pragma unroll
        for (int e = 0; e < 4; ++e) *(LAS unsigned*)(scr + (4 * r16 + e) * 128 + ((i ^ (r16 & 7)) * 16) + q * 4) = cvt_pk_bf16(v[2 * i][e], v[2 * i + 1][e]);
    LDS_WAIT(); asm volatile("" ::: "memory");
    const int c = lane & 7;
#pragma unroll
    for (int j = 0; j < 8; ++j) { const int row = (lane >> 3) + 8 * j; const u32x4 o = *(const LAS u32x4*)(scr + row * 128 + ((c ^ ((row >> 2) & 7)) * 16));
        const int lc = col_off + n0 + row; int dr;
        if (MODE == 0) dr = lc;
        else if (MODE == 1) dr = (lc & ~255) + 128 * ((lc >> 5) & 1) + 32 * ((lc >> 6) & 3) + (lc & 31);
        else if (MODE == 2) dr = 256 * (lc >> 7) + (lc & 127);
        else dr = 256 * (lc >> 7) + 128 + (lc & 127);
        *(u32x4*)(WT + (size_t)dr * (ldt ? ldt : K) + k0 + 8 * c) = o; }
    LDS_WAIT(); asm volatile("" ::: "memory");
}
__device__ __forceinline__ void row_to_bf16_ss(const float* xrow, bf16_t* orow, float* ssp, int lane) {
    const f32x4* xr = (const f32x4*)xrow + lane; u32x2* o8 = (u32x2*)orow + lane; float s = 0.f;
#pragma unroll
    for (int j = 0; j < 16; ++j) { const f32x4 v = xr[64 * j]; s += (v[0] * v[0] + v[1] * v[1]) + (v[2] * v[2] + v[3] * v[3]);
        u32x2 w; w.x = cvt_pk_bf16(v[0], v[1]); w.y = cvt_pk_bf16(v[2], v[3]); o8[64 * j] = w; }
    s = wave_sum(s); if (lane == 0) *ssp = s;
}

struct Args { const float* in[28]; float* out; unsigned char* ws; int ph_lo, ph_hi; };
enum { I_XP = 0, I_XS, I_CAK, I_CAV, I_SPOOL, I_CMK, I_CMV, I_MEMP, I_GMIX, I_WIN, I_QN, I_KN, I_SINK, I_WPOOL, I_PSCALE, I_WOUT, I_GCROSS, I_GMEM, I_WQM, I_WKM, I_WVM, I_QNM, I_KNM, I_WOM, I_GFFN, I_WGATE, I_WUP, I_WDOWN };

#ifndef DEFER_L1
#define DEFER_L1 1
#endif
__device__ __forceinline__ void weights_pass(const Args& a, LAS unsigned char* scr, int gw, int NGW, int lane, int pass) {
    unsigned char* ws = a.ws;
    constexpr int I_IN = 64 * 72, I_PL = 64, I_OUT = 64 * 64, I_QM = 64 * 8, I_OMI = 8 * 64, I_G = 64 * 172, I_DN = 172 * 64;
    constexpr int PER_LAYER = I_IN + I_OUT + 3 * I_QM + I_OMI + 2 * I_G + I_DN;
    for (int it = gw + (pass ? PER_LAYER : 0); it < 2 * PER_LAYER; it += NGW) {
        const int l = it / PER_LAYER; int r = it % PER_LAYER;
        if (DEFER_L1) { const bool early = (l == 0) || (r >= I_IN + I_OUT / 2 && r < I_IN + I_OUT) || (r >= I_IN + I_OUT + I_QM && r < I_IN + I_OUT + 3 * I_QM); if (early != (pass == 0)) continue; }
        else if (pass) continue;
        unsigned char* wl = ws + WS_W + (size_t)l * WL_SIZE;
        if (r < I_IN) { transpose_item<1>(a.in[I_WIN] + (size_t)l * DM * INW, DM, INW, (bf16_t*)(wl + WL_IN), a.in[I_GMIX] + l * DM, nullptr, 0, scr, r, lane); continue; } r -= I_IN;
        if (r < I_OUT / 2) { transpose_item<0>(a.in[I_WOUT] + (size_t)l * DM * DM, 2048, DM, (bf16_t*)(wl + WL_OUT), nullptr, nullptr, 0, scr, r, lane, DM); continue; } r -= I_OUT / 2;
        if (r < I_OUT / 2) { transpose_item<0>(a.in[I_WOUT] + (size_t)l * DM * DM + (size_t)2048 * DM, 2048, DM, (bf16_t*)(ws + WS_WLOW) + (size_t)l * DM * 2048, nullptr, nullptr, 0, scr, r, lane); continue; } r -= I_OUT / 2;
        if (r < I_QM) { transpose_item<0>(a.in[I_WQM] + (size_t)l * DM * MW, DM, MW, (bf16_t*)(wl + WL_Q), a.in[I_GCROSS] + l * DM, nullptr, 0, scr, r, lane); continue; } r -= I_QM;
        if (r < I_QM) { transpose_item<1>(a.in[I_WKM] + (size_t)l * DM * MW, DM, MW, (bf16_t*)(ws + WS_WKV) + (size_t)l * 1024 * DM, a.in[I_GMEM] + l * DM, nullptr, 0, scr, r, lane); continue; } r -= I_QM;
        if (r < I_QM) { transpose_item<1>(a.in[I_WVM] + (size_t)l * DM * MW, DM, MW, (bf16_t*)(ws + WS_WKV) + (size_t)l * 1024 * DM, a.in[I_GMEM] + l * DM, nullptr, 512, scr, r, lane); continue; } r -= I_QM;
        if (r < I_OMI) { transpose_item<0>(a.in[I_WOM] + (size_t)l * MW * DM, MW, DM, (bf16_t*)(wl + WL_OM), nullptr, nullptr, 0, scr, r, lane); continue; } r -= I_OMI;
        if (r < I_G) { transpose_item<2>(a.in[I_WGATE] + (size_t)l * DM * DFF, DM, DFF, (bf16_t*)(wl + WL_GU), a.in[I_GFFN] + l * DM, nullptr, 0, scr, r, lane); continue; } r -= I_G;
        if (r < I_G) { transpose_item<3>(a.in[I_WUP] + (size_t)l * DM * DFF, DM, DFF, (bf16_t*)(wl + WL_GU), a.in[I_GFFN] + l * DM, nullptr, 0, scr, r, lane); continue; } r -= I_G;
        transpose_item<0>(a.in[I_WDOWN] + (size_t)l * DFF * DM, DFF, DM, (bf16_t*)(wl + WL_D), nullptr, nullptr, 0, scr, r, lane);
    }
}
__device__ __forceinline__ void p0_prologue(const Args& a, LAS unsigned char* lds, int vcu, int G, int tid, int wave, int lane) {
    unsigned char* ws = a.ws;
    LAS unsigned char* scr = lds + wave * 16384;
    const int gw = vcu * 8 + wave, NGW = G * 8;
    weights_pass(a, scr, gw, NGW, lane, 0);
    float* ss0 = (float*)(ws + WS_SS); float* ssm = (float*)(ws + WS_SSM);
    for (int m = gw; m < M + NMEM; m += NGW) {
        if (m < MP) row_to_bf16_ss(a.in[I_XP] + (size_t)m * DM, (bf16_t*)(ws + WS_XB) + (size_t)m * DM, ss0 + m, lane);
        else if (m < M) row_to_bf16_ss(a.in[I_XS] + (size_t)(m - MP) * DM, (bf16_t*)(ws + WS_XB) + (size_t)m * DM, ss0 + m, lane);
        else row_to_bf16_ss(a.in[I_MEMP] + (size_t)(m - M) * DM, (bf16_t*)(ws + WS_MEMB) + (size_t)(m - M) * DM, ssm + (m - M), lane);
    }
    const int gt = vcu * 512 + tid, NGT = G * 512;
    for (int i = gt; i < 2 * 4 * 512 * 512 / 4; i += NGT) {
        const int e = i * 4, l = e >> 20, g = (e >> 18) & 3, dd = e & 511;
        const f32x4 w = ((const f32x4*)a.in[I_WPOOL])[i] * *(const f32x4*)(a.in[I_PSCALE] + l * PW + g * 512 + dd);
        u32x2 o; o.x = cvt_pk_bf16(w[0], w[1]); o.y = cvt_pk_bf16(w[2], w[3]);
        *(u32x2*)(ws + WS_W + (size_t)l * WL_SIZE + WL_P + (size_t)(e & 0xfffff) * 2) = o;
    }
    for (int i = gt; i < 2 * 8 * 128 * 256 / 4; i += NGT) {
        const f32x4 kv = ((const f32x4*)a.in[I_CAK])[i], vv = ((const f32x4*)a.in[I_CAV])[i];
        u32x2 w; w.x = cvt_pk_bf16(kv[0], kv[1]); w.y = cvt_pk_bf16(kv[2], kv[3]); ((u32x2*)(ws + WS_CK))[i] = w;
        w.x = cvt_pk_bf16(vv[0], vv[1]); w.y = cvt_pk_bf16(vv[2], vv[3]); ((u32x2*)(ws + WS_CV))[i] = w;
        const int e = i * 4, row = (e >> 8) & 127, lb = e >> 15;
        if (row >= 64) { const size_t o = ((size_t)lb * 128 + (row - 64)) * 256 + (e & 255);
            *(f32x4*)(a.out + O_AKS + o) = kv; *(f32x4*)(a.out + O_AVS + o) = vv; }
    }
    for (int i = gt; i < 2 * 8 * 256 * 512 / 4; i += NGT) {
        const f32x4 kv = ((const f32x4*)a.in[I_CMK])[i], vv = ((const f32x4*)a.in[I_CMV])[i];
        u32x2 w; w.x = cvt_pk_bf16(kv[0], kv[1]); w.y = cvt_pk_bf16(kv[2], kv[3]); ((u32x2*)(ws + WS_MKS))[i] = w;
        w.x = cvt_pk_bf16(vv[0], vv[1]); w.y = cvt_pk_bf16(vv[2], vv[3]); ((u32x2*)(ws + WS_MVS))[i] = w;
    }
}

__device__ __forceinline__ void mem_finalize(const Args& a, int vcu, int G, int wave, int lane) {
    unsigned char* ws = a.ws;
    const int gw = vcu * 8 + wave, NGW = G * 8;
    for (int it = gw; it < 2 * NMEM; it += NGW) {
        const int l = it >> 8, m = it & 255;
        const float* raw = (const float*)(ws + WS_MEMRAW) + ((size_t)l * 256 + m) * 1024;
        const float* kg = a.in[I_KNM] + l * 128;
        float* ok = a.out + O_MKP + ((size_t)l * 256 + m) * 512; float* ov = a.out + O_MVP + ((size_t)l * 256 + m) * 512;
        bf16_t* bk = (bf16_t*)(ws + WS_MKB) + ((size_t)l * 256 + m) * 512; bf16_t* bv = (bf16_t*)(ws + WS_MVB) + ((size_t)l * 256 + m) * 512;
#pragma unroll
        for (int h = 0; h < 4; ++h) { const f32x2 v = *(const f32x2*)(raw + h * 128 + 2 * lane); const float s = wave_sum(v[0] * v[0] + v[1] * v[1]);
            const float hs = rsq(s * (1.0f / 128.0f) + EPS); const f32x2 g = *(const f32x2*)(kg + 2 * lane);
            const f32x2 o = {v[0] * hs * g[0], v[1] * hs * g[1]}; *(f32x2*)(ok + h * 128 + 2 * lane) = o; *(unsigned*)(bk + h * 128 + 2 * lane) = cvt_pk_bf16(o[0], o[1]); }
#pragma unroll
        for (int j = 0; j < 2; ++j) { const f32x4 v = *(const f32x4*)(raw + 512 + j * 256 + 4 * lane); *(f32x4*)(ov + j * 256 + 4 * lane) = v;
            u32x2 w; w.x = cvt_pk_bf16(v[0], v[1]); w.y = cvt_pk_bf16(v[2], v[3]); *(u32x2*)(bv + j * 256 + 4 * lane) = w; }
    }
}

template <int W>
__device__ __forceinline__ void pool_diff_item(const bf16_t* U, bf16_t* Dd, const float* st, int r0, int c0) {
    constexpr int NR = 8 + W - 1;
    u32x4 x[NR];
    if (r0 < MP) {
#pragma unroll
        for (int j = 0; j < NR; ++j) { const int rr = r0 - (W - 1) + j; x[j] = (rr >= 0) ? *(const u32x4*)(U + (size_t)rr * PW + c0) : (u32x4){0u, 0u, 0u, 0u}; }
    } else {
        const int sr = r0 - MP, b = sr >> 6, t0 = sr & 63;
#pragma unroll
        for (int j = 0; j < NR; ++j) { const int idx = t0 - (W - 1) + j;
            if (idx >= 0) x[j] = *(const u32x4*)(U + (size_t)(r0 - (W - 1) + j) * PW + c0);
            else { const float* sp = st + ((size_t)b * 15 + (15 + idx)) * PW + c0; const f32x4 s0 = *(const f32x4*)sp, s1 = *(const f32x4*)(sp + 4);
                x[j] = (u32x4){cvt_pk_bf16(s0[0], s0[1]), cvt_pk_bf16(s0[2], s0[3]), cvt_pk_bf16(s1[0], s1[1]), cvt_pk_bf16(s1[2], s1[3])}; } }
    }
#pragma unroll
    for (int t = 0; t < 8; ++t) {
        const int r = r0 + t;
        float inv = 1.0f / (float)W; if (r < MP && r + 1 < W) inv = 1.0f / (float)(r + 1);
        float sum[8];
#pragma unroll
        for (int e = 0; e < 8; ++e) sum[e] = 0.f;
#pragma unroll
        for (int i = W - 1; i >= 0; --i) { const u32x4 v = x[t + (W - 1) - i];
#pragma unroll
            for (int e = 0; e < 4; ++e) { sum[2 * e] += __uint_as_float(v[e] << 16); sum[2 * e + 1] += __uint_as_float(v[e] & 0xffff0000u); } }
        const u32x4 cur = x[t + (W - 1)]; u32x4 o;
#pragma unroll
        for (int e = 0; e < 4; ++e) o[e] = cvt_pk_bf16(sum[2 * e] * inv - __uint_as_float(cur[e] << 16), sum[2 * e + 1] * inv - __uint_as_float(cur[e] & 0xffff0000u));
        *(u32x4*)(Dd + (size_t)r * DM + c0) = o;
    }
}
__device__ __forceinline__ void pool_diff(const Args& a, int l, int vcu, int G, int tid) {
    unsigned char* ws = a.ws;
    const bf16_t* U = (const bf16_t*)(ws + WS_U); bf16_t* Dd = (bf16_t*)(ws + WS_MIX) + 2048;
    const float* st = a.in[I_SPOOL] + (size_t)l * 8 * 15 * PW;
    int it0, it1;
    if (G == 256) { const int bx = (int)blockIdx.x; const int c0w = bx < 64 ? bx : 64 + 2 * (bx - 64), c1w = bx < 64 ? bx + 1 : 66 + 2 * (bx - 64);
        it0 = ((M / 8) * c0w / 448) * 256; it1 = ((M / 8) * c1w / 448) * 256; }
    else { it0 = (int)(((long)(M / 8) * vcu / G)) * 256; it1 = (int)(((long)(M / 8) * (vcu + 1) / G)) * 256; }
    for (int it = it0 + tid; it < it1; it += 512) {
        const int r0 = (it >> 8) * 8, c0 = (it & 255) * 8, g = __builtin_amdgcn_readfirstlane(c0 >> 9);
        if (g == 0) pool_diff_item<2>(U, Dd, st, r0, c0);
        else if (g == 1) pool_diff_item<4>(U, Dd, st, r0, c0);
        else if (g == 2) pool_diff_item<8>(U, Dd, st, r0, c0);
        else pool_diff_item<16>(U, Dd, st, r0, c0);
    }
}

constexpr int SWA_LD = 144;
constexpr int SWA_K_OFF = 0, SWA_V_OFF = 192 * SWA_LD;
typedef short v4i16_t __attribute__((ext_vector_type(4)));
__device__ __forceinline__ s16x4 lds_tr16(const LAS unsigned char* p) { return __builtin_bit_cast(s16x4, __builtin_amdgcn_ds_read_tr16_b64_v4i16((LAS v4i16_t*)p)); }
struct SwaStage { u32x4 kx[3], vx[3]; bf16x8 qf[2][2]; };
__device__ __forceinline__ void swa_load(SwaStage& S, int L, const bf16_t* Q, const bf16_t* Kb, const bf16_t* Vb, const bf16_t* CK, const bf16_t* CV, int tid, int wid, int lane) {
    const int cidx = L >> 3, kvh = (L >> 1) & 3, hp = L & 1;
    const bool samp = cidx >= 128; const int row0 = samp ? MP + 64 * (cidx - 128) : 64 * cidx;
#pragma unroll
    for (int i = 0; i < 3; ++i) { const int p = tid + 512 * i, kk = p >> 3, pc = p & 7;
        const bf16_t *ks, *vs;
        if (samp && kk < 128) { const size_t o = ((size_t)(cidx - 128) * 128 + kk) * 256 + kvh * 64 + pc * 8; ks = CK + o; vs = CV + o; }
        else { int gr = row0 - 128 + kk; if (gr < 0) gr = 0; const size_t o = (size_t)gr * 256 + kvh * 64 + pc * 8; ks = Kb + o; vs = Vb + o; }
        S.kx[i] = *(const u32x4*)ks; S.vx[i] = *(const u32x4*)vs; }
    const int h = kvh * 8 + wid, fr = lane & 15, fq = lane >> 4;
#pragma unroll
    for (int pi = 0; pi < 2; ++pi)
#pragma unroll
        for (int ds = 0; ds < 2; ++ds) S.qf[pi][ds] = *(const bf16x8*)(Q + (size_t)(row0 + 16 * (2 * hp + pi) + fr) * AW + h * 64 + 32 * ds + 8 * fq);
}
__device__ __forceinline__ void swa_write(const SwaStage& S, LAS unsigned char* buf, int tid) {
#pragma unroll
    for (int i = 0; i < 3; ++i) { const int p = tid + 512 * i, kk = p >> 3, pc = p & 7;
        *(LAS u32x4*)(buf + SWA_K_OFF + kk * SWA_LD + pc * 16) = S.kx[i];
        *(LAS u32x4*)(buf + SWA_V_OFF + kk * SWA_LD + pc * 16) = S.vx[i]; }
}
__device__ __forceinline__ void swa_compute(const LAS unsigned char* buf, int L, const bf16x8 (&qfa)[2][2], const float* sinks, bf16_t* MIX, int wid, int lane) {
    const int cidx = L >> 3, kvh = (L >> 1) & 3, hp = L & 1;
    const bool samp = cidx >= 128;
    const int row0 = samp ? MP + 64 * (cidx - 128) : 64 * cidx;
    const int kk0 = (cidx < 2) ? 128 - 64 * cidx : 0;
    const int h = kvh * 8 + wid, fr = lane & 15, fq = lane >> 4;
    const float slope2 = ex2(-(float)(h + 1) * 0.25f) * LOG2E, sink2 = sinks[h] * LOG2E, nslope = -slope2;
    float ns_cf[4];
#pragma unroll
    for (int r = 0; r < 4; ++r) ns_cf[r] = nslope * (float)(fr - 4 * fq - r);
    const LAS unsigned char* kbase = buf + SWA_K_OFF + fr * SWA_LD + fq * 16;
    const LAS unsigned char* vbase = buf + SWA_V_OFF + (4 * fq + (fr >> 2)) * SWA_LD + (fr & 3) * 8;
    f32x4 s[2][12];
#pragma unroll
    for (int blk = 0; blk < 12; ++blk) {
#pragma unroll
        for (int pi = 0; pi < 2; ++pi) { const float cd = nslope * (float)(16 * (2 * hp + pi + 8 - blk));
#pragma unroll
            for (int r = 0; r < 4; ++r) s[pi][blk][r] = -__builtin_fabsf(ns_cf[r] + cd); }
#pragma unroll
        for (int ds = 0; ds < 2; ++ds) { const bf16x8 kf = *(const LAS bf16x8*)(kbase + blk * 16 * SWA_LD + ds * 64);
#pragma unroll
            for (int pi = 0; pi < 2; ++pi) s[pi][blk] = __builtin_amdgcn_mfma_f32_16x16x32_bf16(kf, qfa[pi][ds], s[pi][blk], 0, 0, 0); } }
    if (kk0 > 0) {
#pragma unroll
        for (int pi = 0; pi < 2; ++pi)
#pragma unroll
            for (int blk = 0; blk < 8; ++blk)
#pragma unroll
                for (int r = 0; r < 4; ++r) if (16 * blk + 4 * fq + r < kk0) s[pi][blk][r] = -1e30f;
    }
    float inv[2], sinkp[2]; bf16x8 pf[2][6];
#pragma unroll
    for (int pi = 0; pi < 2; ++pi) {
        float mx = sink2;
#pragma unroll
        for (int blk = 0; blk < 12; ++blk) { mx = __builtin_fmaxf(__builtin_fmaxf(s[pi][blk][0], s[pi][blk][1]), mx); mx = __builtin_fmaxf(__builtin_fmaxf(s[pi][blk][2], s[pi][blk][3]), mx); }
        mx = __builtin_fmaxf(mx, __shfl_xor(mx, 16)); mx = __builtin_fmaxf(mx, __shfl_xor(mx, 32));
#pragma unroll
        for (int blk = 0; blk < 12; ++blk)
#pragma unroll
            for (int r = 0; r < 4; ++r) s[pi][blk][r] = ex2(s[pi][blk][r] - mx);
        sinkp[pi] = ex2(sink2 - mx);
#pragma unroll
        for (int ks = 0; ks < 6; ++ks) { u32x4 w; w.x = cvt_pk_bf16(s[pi][2 * ks][0], s[pi][2 * ks][1]); w.y = cvt_pk_bf16(s[pi][2 * ks][2], s[pi][2 * ks][3]);
            w.z = cvt_pk_bf16(s[pi][2 * ks + 1][0], s[pi][2 * ks + 1][1]); w.w = cvt_pk_bf16(s[pi][2 * ks + 1][2], s[pi][2 * ks + 1][3]); pf[pi][ks] = __builtin_bit_cast(bf16x8, w); }
    }
    { const bf16x8 ones = {(short)0x3F80, (short)0x3F80, (short)0x3F80, (short)0x3F80, (short)0x3F80, (short)0x3F80, (short)0x3F80, (short)0x3F80};
#pragma unroll
      for (int pi = 0; pi < 2; ++pi) { f32x4 os = (f32x4){0.f, 0.f, 0.f, 0.f};
#pragma unroll
          for (int ks = 0; ks < 6; ++ks) os = __builtin_amdgcn_mfma_f32_16x16x32_bf16(ones, pf[pi][ks], os, 0, 0, 0);
          inv[pi] = 1.0f / (os[0] + sinkp[pi]); } }
#pragma unroll
    for (int db = 0; db < 4; ++db) { f32x4 o[2] = {(f32x4){0.f, 0.f, 0.f, 0.f}, (f32x4){0.f, 0.f, 0.f, 0.f}};
#pragma unroll
        for (int ks = 0; ks < 6; ++ks) { const s16x4 lo = lds_tr16(vbase + (32 * ks) * SWA_LD + db * 32), hi = lds_tr16(vbase + (32 * ks + 16) * SWA_LD + db * 32);
            const bf16x8 vf = {lo[0], lo[1], lo[2], lo[3], hi[0], hi[1], hi[2], hi[3]};
#pragma unroll
            for (int pi = 0; pi < 2; ++pi) o[pi] = __builtin_amdgcn_mfma_f32_16x16x32_bf16(vf, pf[pi][ks], o[pi], 0, 0, 0); }
#pragma unroll
        for (int pi = 0; pi < 2; ++pi) { const size_t qrow = (size_t)(row0 + 16 * (2 * hp + pi) + fr);
            u32x2 w; w.x = cvt_pk_bf16(o[pi][0] * inv[pi], o[pi][1] * inv[pi]); w.y = cvt_pk_bf16(o[pi][2] * inv[pi], o[pi][3] * inv[pi]);
            *(u32x2*)(MIX + qrow * DM + h * 64 + 16 * db + 4 * fq) = w; } }
}
constexpr int SWA_DEP_L = 112 * 8;
__device__ __forceinline__ bool swa_phase(LAS unsigned char* lds, int bx, int G, const bf16_t* Q, const bf16_t* Kb, const bf16_t* Vb, const bf16_t* CK, const bf16_t* CV,
                                          const float* sinks, bf16_t* MIX, int tid, int wid, int lane, const XcdBarrier& b, unsigned* spc) {
    constexpr int NU = 136 * 8, BUFB = 2 * 192 * SWA_LD;
    if (bx >= NU) return false;
    bool acq = false;
    if (bx >= SWA_DEP_L) { sp_wait(b, spc); acq = true; }
    SwaStage S; swa_load(S, bx, Q, Kb, Vb, CK, CV, tid, wid, lane);
    int par = 0;
    for (int L = bx; L < NU; L += G, par ^= 1) {
        if (!acq && L + G >= SWA_DEP_L && L + G < NU) { sp_wait(b, spc); acq = true; }
        LAS unsigned char* buf = lds + par * BUFB;
        swa_write(S, buf, tid);
        bf16x8 qfa[2][2];
#pragma unroll
        for (int pi = 0; pi < 2; ++pi)
#pragma unroll
            for (int ds = 0; ds < 2; ++ds) qfa[pi][ds] = S.qf[pi][ds];
        __syncthreads();
        if (L + G < NU) swa_load(S, L + G, Q, Kb, Vb, CK, CV, tid, wid, lane);
        swa_compute(buf, L, qfa, sinks, MIX, wid, lane);
    }
    __syncthreads();
    return acq;
}

constexpr int CA_LD = 272;
constexpr int CA_K_OFF = 0, CA_V_OFF = 256 * CA_LD;
__device__ __forceinline__ void cross_unit(LAS unsigned char* lds, int rowbase, int nrows, int h, const bf16_t* Km, const bf16_t* Vm, const bf16_t* QP, const float* ss, const float* qg,
                                           bf16_t* OM, int tid, int wid, int lane) {
    const int fr = lane & 15, fq = lane >> 4;
    u32x4 kx[8], vx[8];
#pragma unroll
    for (int i = 0; i < 8; ++i) { const int p = tid + 512 * i, mr = p >> 4, pc = p & 15; const size_t o = (size_t)mr * 512 + h * 128 + pc * 8;
        kx[i] = *(const u32x4*)(Km + o); vx[i] = *(const u32x4*)(Vm + o); }
    u32x4 qraw[2][4][3]; float ssv[2];
#pragma unroll
    for (int pass = 0; pass < 2; ++pass) { const int rl = pass * 128 + wid * 16;
        if (rl < nrows) { const size_t row = (size_t)(rowbase + rl + fr); ssv[pass] = ss[row];
#pragma unroll
            for (int ds = 0; ds < 4; ++ds)
#pragma unroll
                for (int sp = 0; sp < 3; ++sp) qraw[pass][ds][sp] = *(const u32x4*)(QP + (size_t)sp * M * 512 + row * 512 + h * 128 + 32 * ds + 8 * fq); } }
#pragma unroll
    for (int i = 0; i < 8; ++i) { const int p = tid + 512 * i, mr = p >> 4, pc = p & 15;
        *(LAS u32x4*)(lds + CA_K_OFF + mr * CA_LD + pc * 16) = kx[i];
        *(LAS u32x4*)(lds + CA_V_OFF + mr * CA_LD + pc * 16) = vx[i]; }
    __syncthreads();
    const LAS unsigned char* vbase = lds + CA_V_OFF + (4 * fq + (fr >> 2)) * CA_LD + (fr & 3) * 8;
#pragma unroll
    for (int pass = 0; pass < 2; ++pass) {
        const int rl = pass * 128 + wid * 16;
        if (rl < nrows) {
            const size_t row = (size_t)(rowbase + rl + fr);
            const float rs = rsq(ssv[pass] * (1.0f / 4096.0f) + EPS);
            f32x4 qa[4][2]; float sq = 0.f;
#pragma unroll
            for (int ds = 0; ds < 4; ++ds) { f32x4 s0 = (f32x4){0.f, 0.f, 0.f, 0.f}, s1 = s0;
#pragma unroll
                for (int sp = 0; sp < 3; ++sp) { const u32x4 x = qraw[pass][ds][sp];
                    s0 += (f32x4){__uint_as_float(x.x << 16), __uint_as_float(x.x & 0xffff0000u), __uint_as_float(x.y << 16), __uint_as_float(x.y & 0xffff0000u)};
                    s1 += (f32x4){__uint_as_float(x.z << 16), __uint_as_float(x.z & 0xffff0000u), __uint_as_float(x.w << 16), __uint_as_float(x.w & 0xffff0000u)}; }
                const f32x4 v0 = s0 * rs, v1 = s1 * rs; qa[ds][0] = v0; qa[ds][1] = v1;
                sq += (v0[0] * v0[0] + v0[1] * v0[1]) + (v0[2] * v0[2] + v0[3] * v0[3]) + (v1[0] * v1[0] + v1[1] * v1[1]) + (v1[2] * v1[2] + v1[3] * v1[3]); }
            sq += __shfl_xor(sq, 16); sq += __shfl_xor(sq, 32);
            const float hs = rsq(sq * (1.0f / 128.0f) + EPS) * QMSCALE;
            bf16x8 qf[4];
#pragma unroll
            for (int ds = 0; ds < 4; ++ds) { const f32x4 g0 = *(const f32x4*)(qg + 32 * ds + 8 * fq), g1 = *(const f32x4*)(qg + 32 * ds + 8 * fq + 4);
                const f32x4 v0 = qa[ds][0] * hs * g0, v1 = qa[ds][1] * hs * g1;
                u32x4 w; w.x = cvt_pk_bf16(v0[0], v0[1]); w.y = cvt_pk_bf16(v0[2], v0[3]); w.z = cvt_pk_bf16(v1[0], v1[1]); w.w = cvt_pk_bf16(v1[2], v1[3]); qf[ds] = __builtin_bit_cast(bf16x8, w); }
            f32x4 s[16];
#pragma unroll
            for (int blk = 0; blk < 16; ++blk) { s[blk] = (f32x4){0.f, 0.f, 0.f, 0.f};
#pragma unroll
                for (int ds = 0; ds < 4; ++ds) { const bf16x8 kf = *(const LAS bf16x8*)(lds + CA_K_OFF + (16 * blk + fr) * CA_LD + (32 * ds + 8 * fq) * 2);
                    s[blk] = __builtin_amdgcn_mfma_f32_16x16x32_bf16(kf, qf[ds], s[blk], 0, 0, 0); } }
            float mx = -1e30f;
#pragma unroll
            for (int blk = 0; blk < 16; ++blk) { mx = __builtin_fmaxf(__builtin_fmaxf(s[blk][0], s[blk][1]), mx); mx = __builtin_fmaxf(__builtin_fmaxf(s[blk][2], s[blk][3]), mx); }
            mx = __builtin_fmaxf(mx, __shfl_xor(mx, 16)); mx = __builtin_fmaxf(mx, __shfl_xor(mx, 32));
            float sum0 = 0.f, sum1 = 0.f;
#pragma unroll
            for (int blk = 0; blk < 16; ++blk) {
#pragma unroll
                for (int r = 0; r < 4; ++r) s[blk][r] = ex2(s[blk][r] - mx);
                sum0 += s[blk][0] + s[blk][1]; sum1 += s[blk][2] + s[blk][3]; }
            float sum = sum0 + sum1;
            sum += __shfl_xor(sum, 16); sum += __shfl_xor(sum, 32);
            const float inv = 1.0f / sum;
            bf16x8 pf[8];
#pragma unroll
            for (int ks = 0; ks < 8; ++ks) { u32x4 w; w.x = cvt_pk_bf16(s[2 * ks][0], s[2 * ks][1]); w.y = cvt_pk_bf16(s[2 * ks][2], s[2 * ks][3]);
                w.z = cvt_pk_bf16(s[2 * ks + 1][0], s[2 * ks + 1][1]); w.w = cvt_pk_bf16(s[2 * ks + 1][2], s[2 * ks + 1][3]); pf[ks] = __builtin_bit_cast(bf16x8, w); }
#pragma unroll
            for (int db = 0; db < 8; ++db) { f32x4 o = (f32x4){0.f, 0.f, 0.f, 0.f};
#pragma unroll
                for (int ks = 0; ks < 8; ++ks) { const s16x4 lo = lds_tr16(vbase + (32 * ks) * CA_LD + db * 32), hi = lds_tr16(vbase + (32 * ks + 16) * CA_LD + db * 32);
                    const bf16x8 vf = {lo[0], lo[1], lo[2], lo[3], hi[0], hi[1], hi[2], hi[3]};
                    o = __builtin_amdgcn_mfma_f32_16x16x32_bf16(vf, pf[ks], o, 0, 0, 0); }
                u32x2 w; w.x = cvt_pk_bf16(o[0] * inv, o[1] * inv); w.y = cvt_pk_bf16(o[2] * inv, o[3] * inv);
                *(u32x2*)(OM + row * 512 + h * 128 + 16 * db + 4 * fq) = w; }
        }
    }
    __syncthreads();
}

constexpr int N_PHASES = 1 + 12 * DEPTH;
__global__ void __launch_bounds__(512, 2) fwd(Args args) {
    __shared__ __attribute__((aligned(16))) unsigned char lds_raw[LDS_BYTES];
    LAS unsigned char* lds = (LAS unsigned char*)lds_raw;
    volatile LAS unsigned* MISC = (volatile LAS unsigned*)(lds + MISC_OFF);
    const int tid = threadIdx.x, lane = tid & 63, wave = __builtin_amdgcn_readfirstlane(tid >> 6);
    const int G = gridDim.x, bx = blockIdx.x; const int vcu = (G % 8 == 0) ? (bx % 8) * (G / 8) + bx / 8 : bx;
    unsigned char* ws = args.ws;
    unsigned* ctl = (unsigned*)(ws + WS_CTL);
    if (tid < 32) MISC[tid] = 0u;
    __syncthreads();
    XcdBarrier bar; bar.bar = ctl + CW_BAR; bar.x = 0; bar.st = nullptr;
#if !MK_SPLIT
    bar = xcd_barrier_post(ctl + CW_BAR, MISC + 8);
#endif
    const int lo = args.ph_lo, hi = args.ph_hi;
#define IN(k) (lo <= (k) && (k) < hi)
#if MK_SPLIT
#define SEAM(k) do { } while (0)
#else
#define SEAM(k) do { if (IN(k) && IN((k) + 1)) xcd_barrier(bar); } while (0)
#endif
#define FRESH_IDS() int tid_ = threadIdx.x; asm volatile("" : "+v"(tid_)); const int lane_ = tid_ & 63, wave_ = __builtin_amdgcn_readfirstlane(tid_ >> 6)
    float* ssb = (float*)(ws + WS_SS);
    bf16_t* XB = (bf16_t*)(ws + WS_XB); bf16_t* QB = (bf16_t*)(ws + WS_Q); bf16_t* KB = (bf16_t*)(ws + WS_K); bf16_t* VB = (bf16_t*)(ws + WS_V);
    bf16_t* UB = (bf16_t*)(ws + WS_U); bf16_t* MIX = (bf16_t*)(ws + WS_MIX); bf16_t* QP = (bf16_t*)(ws + WS_QP);
    bf16_t* OMB = (bf16_t*)(ws + WS_OM); bf16_t* HB = (bf16_t*)(ws + WS_H);

    if (PH_ON(12) && IN(0)) REP(12) { FRESH_IDS(); p0_prologue(args, lds, vcu, G, tid_, wave_, lane_); }
    SEAM(0);

    for (int l = 0; l < DEPTH; ++l) {
        const int pb = 1 + 12 * l;
        unsigned char* wl = ws + WS_W + (size_t)l * WL_SIZE;
        typedef pg::DescTail<4096, 4096, 18, 64, 28, 2> DIn;
        typedef pg::DescTail<4096, 4096, 16, 64, 32, 8> DOut;
        typedef pg::DescTail<DFF, DFF, 16, 172, 32, 8> DDn;
        if ((PH_ON(0) && IN(pb)) || (PH_ON(1) && IN(pb + 1))) {
            DIn D{XB, (const bf16_t*)(wl + WL_IN), (const bf16_t*)(ws + WS_MEMB), (const bf16_t*)(ws + WS_WKV), l == 0 ? 8 : 0, ws + WS_SLAB, l > 0 ? ctl + CW_SP + 2 * SP_WORDS + SP_TOP : nullptr, MISC[9]};
            pg::EpiInProj E{ssb + (3 * l) * SS_STRIDE, (const float*)(ws + WS_SSM), args.in[I_QN] + l * 64, args.in[I_KN] + l * 64, QB, KB, VB, UB, (float*)(ws + WS_MEMRAW),
                            args.out + O_AKP + (size_t)l * 128 * 256, args.out + O_AVP + (size_t)l * 128 * 256, args.out + O_PLP + (size_t)l * 15 * 2048,
                            args.out + O_AKS + (size_t)l * 8 * 128 * 256, args.out + O_AVS + (size_t)l * 8 * 128 * 256, args.out + O_PLS + (size_t)l * 8 * 15 * 2048};
            if (PH_ON(0) && IN(pb)) REP(0) pg::gemm_phase<DIn, pg::EpiInProj, true>(lds, D, E, G, bx);
            SEAM(pb);
            if (PH_ON(1) && IN(pb + 1)) { FRESH_IDS(); pg::reduce_pass<DIn, pg::EpiInProj>(D, E, vcu, G, wave_, lane_); }
        }
        if (l == 0 && PH_ON(13) && IN(pb + 1)) REP(13) {
            pg::DescFold D{(const bf16_t*)(ws + WS_WLOW), (const bf16_t*)(ws + WS_W + WL_P), 2048, 512};
            pg::EpiFold E{ws + WS_W + WL_OUT};
            pg::gemm_phase<pg::DescFold, pg::EpiFold, true>(lds, D, E, G, bx);
        }
        if (IN(pb + 1)) sp_arrive(bar, ctl + CW_SP + (3 + l) * SP_WORDS);
        if (PH_ON(2) && IN(pb + 2)) REP(2) {
            FRESH_IDS();
            const bf16_t* CK = (const bf16_t*)(ws + WS_CK) + (size_t)l * 8 * 128 * 256; const bf16_t* CV = (const bf16_t*)(ws + WS_CV) + (size_t)l * 8 * 128 * 256;
            if (!swa_phase(lds, bx, G, QB, KB, VB, CK, CV, args.in[I_SINK] + l * NHEAD, MIX, tid_, wave_, lane_, bar, ctl + CW_SP + (3 + l) * SP_WORDS)) sp_wait(bar, ctl + CW_SP + (3 + l) * SP_WORDS);
            pool_diff(args, l, vcu, G, tid_);
            if (l == 0) mem_finalize(args, vcu, G, wave_, lane_);
        }
        SEAM(pb + 2);
        if ((PH_ON(3) && IN(pb + 3)) || (PH_ON(4) && IN(pb + 4))) {
            DOut D{MIX, (const bf16_t*)(wl + WL_OUT), nullptr, nullptr, 0, ws + WS_SLAB};
            pg::EpiResid E{XB, ssb + (3 * l + 1) * SS_STRIDE, nullptr};
            if (PH_ON(3) && IN(pb + 3)) { if (PROBE_DUP == 3) { pg::EpiResid Ed{XB, (float*)(ws + WS_DUMSS), (float*)(ws + WS_DUMX)}; pg::gemm_phase<DOut, pg::EpiResid, true>(lds, D, Ed, G, bx); }
                pg::gemm_phase<DOut, pg::EpiResid, true>(lds, D, E, G, bx); }
            SEAM(pb + 3);
            if (PH_ON(4) && IN(pb + 4)) { FRESH_IDS(); pg::reduce_pass<DOut, pg::EpiResid>(D, E, vcu, G, wave_, lane_); }
        }
        SEAM(pb + 4);
        if (PH_ON(5) && IN(pb + 5)) REP(5) {
            pg::DescSplitK D{XB, (const bf16_t*)(wl + WL_Q), 4096, 4096};
            pg::EpiF32Part E{QP};
            pg::gemm_phase<pg::DescSplitK, pg::EpiF32Part, true>(lds, D, E, G, bx);
        }
        SEAM(pb + 5);
        if (PH_ON(6) && IN(pb + 6)) REP(6) {
            FRESH_IDS();
            const float* ssc = ssb + (3 * l + 1) * SS_STRIDE; const float* qg = args.in[I_QNM] + l * 128;
            for (int L = bx; L < 160; L += G) {
                if (L < 128) cross_unit(lds, (L >> 2) * 256, 256, L & 3, (const bf16_t*)(ws + WS_MKB) + (size_t)l * 256 * 512, (const bf16_t*)(ws + WS_MVB) + (size_t)l * 256 * 512, QP, ssc, qg, OMB, tid_, wave_, lane_);
                else { const int b = (L - 128) >> 2; cross_unit(lds, MP + 64 * b, 64, L & 3, (const bf16_t*)(ws + WS_MKS) + ((size_t)l * 8 + b) * 256 * 512, (const bf16_t*)(ws + WS_MVS) + ((size_t)l * 8 + b) * 256 * 512, QP, ssc, qg, OMB, tid_, wave_, lane_); }
            }
        }
        SEAM(pb + 6);
        if (PH_ON(7) && IN(pb + 7)) {
            pg::DescPlain D{OMB, (const bf16_t*)(wl + WL_OM), 512, 512, 16, 8};
            pg::EpiResid E{XB, ssb + (3 * l + 2) * SS_STRIDE, nullptr};
            if (PROBE_DUP == 7) { pg::EpiResid Ed{XB, (float*)(ws + WS_DUMSS), (float*)(ws + WS_DUMX)}; pg::gemm_phase<pg::DescPlain, pg::EpiResid, true>(lds, D, Ed, G, bx); }
            pg::gemm_phase<pg::DescPlain, pg::EpiResid, true>(lds, D, E, G, bx);
        }
        SEAM(pb + 7);
        if ((PH_ON(8) && IN(pb + 8)) || (PH_ON(9) && IN(pb + 9))) {
            pg::DescGU D{XB, (const bf16_t*)(wl + WL_GU), ws + WS_SLAB};
            pg::EpiSwiGLU E{ssb + (3 * l + 2) * SS_STRIDE, HB};
            if (PH_ON(8) && IN(pb + 8)) REP(8) pg::gemm_phase<pg::DescGU, pg::EpiSwiGLU, true>(lds, D, E, G, bx);
            SEAM(pb + 8);
            if (PH_ON(9) && IN(pb + 9)) { FRESH_IDS(); pg::reduce_pass<pg::DescGU, pg::EpiSwiGLU>(D, E, vcu, G, wave_, lane_); }
        }
        if (DEFER_L1 && l == 0 && IN(pb + 9)) { FRESH_IDS(); weights_pass(args, lds + wave_ * 16384, vcu * 8 + wave_, G * 8, lane_, 1); }
        if (IN(pb + 9)) sp_arrive(bar, ctl + CW_SP + l * SP_WORDS);
        if ((PH_ON(10) && IN(pb + 10)) || (PH_ON(11) && IN(pb + 11))) {
            DDn D{HB, (const bf16_t*)(wl + WL_D), nullptr, nullptr, 0, ws + WS_SLAB, ctl + CW_SP + l * SP_WORDS + SP_TOP, MISC[9]};
            pg::EpiResid E{XB, ssb + (3 * l + 3) * SS_STRIDE, l + 1 < DEPTH ? nullptr : args.out};
            if (PH_ON(10) && IN(pb + 10)) { if (PROBE_DUP == 10) { pg::EpiResid Ed{XB, (float*)(ws + WS_DUMSS), (float*)(ws + WS_DUMX)}; pg::gemm_phase<DDn, pg::EpiResid, true>(lds, D, Ed, G, bx); }
                pg::gemm_phase<DDn, pg::EpiResid, true>(lds, D, E, G, bx); }
            SEAM(pb + 10);
            if (PH_ON(11) && IN(pb + 11)) { FRESH_IDS(); pg::reduce_pass<DDn, pg::EpiResid>(D, E, vcu, G, wave_, lane_); }
        }
        if (l + 1 < DEPTH && IN(pb + 11)) sp_arrive(bar, ctl + CW_SP + 2 * SP_WORDS);
    }
#undef IN
#undef SEAM
#undef FRESH_IDS
}

extern "C" void kernel_launch(void* const* d_in, const int* in_sizes, int n_in, void* d_out, int out_size, void* d_ws, size_t ws_size, hipStream_t stream) {
    static int grid = 0;
    if (grid == 0) {
        if (n_in != 28 || out_size != (int)O_END || ws_size < WS_END) { fprintf(stderr, "kernel_launch: unexpected shapes (n_in %d out %d ws %zu)\n", n_in, out_size, ws_size); grid = -1; return; }
        int dev = 0, cus = 0;
        if (hipGetDevice(&dev) != hipSuccess || hipDeviceGetAttribute(&cus, hipDeviceAttributeMultiprocessorCount, dev) != hipSuccess) { grid = -1; return; }
        int per_cu = 0;
        if (hipOccupancyMaxActiveBlocksPerMultiprocessor(&per_cu, (const void*)fwd, 512, 0) != hipSuccess || per_cu < 1) { fprintf(stderr, "kernel_launch: occupancy query says %d\n", per_cu); }
        (void)hipGetLastError();
        grid = cus;
    }
    if (grid < 0) return;
    (void)hipMemsetAsync((char*)d_ws + WS_CTL, 0, CTL_ZERO_BYTES, stream);
    Args a{};
    for (int i = 0; i < 28; ++i) a.in[i] = (const float*)d_in[i];
    a.out = (float*)d_out; a.ws = (unsigned char*)d_ws;
#if MK_SPLIT
    for (int p = 0; p < N_PHASES; ++p) { a.ph_lo = p; a.ph_hi = p + 1; hipLaunchKernelGGL(fwd, dim3(grid), dim3(512), 0, stream, a); }
#else
    a.ph_lo = 0; a.ph_hi = N_PHASES;
    hipLaunchKernelGGL(fwd, dim3(grid), dim3(512), 0, stream, a);
#endif
}
```

```cpp
#include <hip/hip_runtime.h>
#include <cstdio>
#include <cstdint>

#ifndef MK_SPLIT
#define MK_SPLIT 0
#endif

#ifndef PHASE_MASK
#define PHASE_MASK 0x3fff
#endif
#define PH_ON(k) (((PHASE_MASK) >> (k)) & 1)
#ifndef PROBE_DUP
#define PROBE_DUP -1
#endif
#define REP(k) for (int rep_ = 0; rep_ < ((PROBE_DUP == (k)) ? 2 : 1); ++rep_)
#define GAS __attribute__((address_space(1)))
#define LAS __attribute__((address_space(3)))
typedef unsigned short bf16_t;
typedef short bf16x8 __attribute__((ext_vector_type(8)));
typedef short s16x4 __attribute__((ext_vector_type(4)));
typedef float f32x4 __attribute__((ext_vector_type(4)));
typedef float f32x2 __attribute__((ext_vector_type(2)));
typedef unsigned u32x4 __attribute__((ext_vector_type(4)));
typedef unsigned u32x2 __attribute__((ext_vector_type(2)));

constexpr int DM = 4096, MP = 8192, MS = 512, M = MP + MS, NPAN = M / 256;
constexpr int INW = 4608, AW = 2048, KVW = 256, PW = 2048, NHEAD = 32;
constexpr int NMEM = 256, MW = 512, DFF = 11008, DEPTH = 2;
constexpr float EPS = 1e-6f;
constexpr float LOG2E = 1.4426950408889634f;
constexpr float QSCALE = 0.125f * LOG2E;
constexpr float QMSCALE = 0.08838834764831845f * LOG2E;

constexpr size_t O_Y = 0, O_AKP = 35651584, O_AVP = 35717120, O_PLP = 35782656, O_MKP = 35844096, O_MVP = 36106240,
                 O_AKS = 36368384, O_AVS = 36892672, O_PLS = 37416960, O_END = 37908480;

constexpr size_t MiB = 1u << 20;
constexpr size_t WS_CTL = 0, CTL_ZERO_BYTES = 320 * 1024;
constexpr size_t WS_SS = 64 * 1024;
constexpr int    SS_STRIDE = 8704;
constexpr size_t WS_SSM = WS_SS + 7 * 8704 * 4;
constexpr size_t WS_W = 2 * MiB;
constexpr size_t WL_IN = 0, WL_P = 36 * MiB, WL_OUT = 38 * MiB, WL_Q = 70 * MiB, WL_OM = 74 * MiB, WL_GU = 78 * MiB, WL_D = 250 * MiB, WL_SIZE = 336 * MiB;
constexpr size_t WS_WKV = WS_W + 2 * WL_SIZE;
constexpr size_t WS_XB = WS_WKV + 16 * MiB;
constexpr size_t WS_Q = WS_XB + 68 * MiB;
constexpr size_t WS_K = WS_Q + 34 * MiB;
constexpr size_t WS_V = WS_K + 5 * MiB;
constexpr size_t WS_U = WS_V + 5 * MiB;
constexpr size_t WS_WLOW = WS_U + 34 * MiB;
constexpr size_t WS_MIX = WS_WLOW + 34 * MiB;
constexpr size_t WS_QP = WS_MIX + 68 * MiB;
constexpr size_t WS_OM = WS_QP + 51 * MiB;
constexpr size_t WS_H = WS_OM + 9 * MiB;
constexpr size_t WS_MEMB = WS_H + 183 * MiB;
constexpr size_t WS_MEMRAW = WS_MEMB + 2 * MiB;
constexpr size_t WS_MKB = WS_MEMRAW + 2 * MiB;
constexpr size_t WS_MVB = WS_MKB + 1 * MiB;
constexpr size_t WS_MKS = WS_MVB + 1 * MiB;
constexpr size_t WS_MVS = WS_MKS + 4 * MiB;
constexpr size_t WS_CK = WS_MVS + 4 * MiB;
constexpr size_t WS_CV = WS_CK + 1 * MiB;
constexpr size_t WS_SLAB = WS_CV + 1 * MiB;
constexpr size_t WS_END = WS_SLAB + 64 * MiB;
constexpr size_t WS_DUMX = WS_END, WS_DUMXB = WS_DUMX + 136 * MiB, WS_DUMSS = WS_DUMXB + 68 * MiB;
constexpr int CW_BAR = 4096;
constexpr int CW_SP = 8192;
static_assert((CW_BAR + 3456) * 4 <= (int)WS_SS && WS_SS + 7 * 8704 * 4 + 256 * 4 <= CTL_ZERO_BYTES, "control region map");

constexpr int RING_BYTES = 131072, MISC_OFF = RING_BYTES + 8192, LDS_BYTES = 147456;

#define RLX_AGENT __ATOMIC_RELAXED, __HIP_MEMORY_SCOPE_AGENT
#define LDS_WAIT() asm volatile("s_waitcnt lgkmcnt(0)" ::: "memory")
#define VM_WAIT() asm volatile("s_waitcnt vmcnt(0)" ::: "memory")
__device__ __forceinline__ unsigned cvt_pk_bf16(float lo, float hi) { unsigned r; asm volatile("v_cvt_pk_bf16_f32 %0, %1, %2" : "=v"(r) : "v"(lo), "v"(hi)); return r; }
__device__ __forceinline__ float wave_sum(float v) {
#pragma unroll
    for (int o = 1; o < 64; o <<= 1) v += __shfl_xor(v, o);
    return v;
}
__device__ __forceinline__ float ex2(float x) { return __builtin_amdgcn_exp2f(x); }
__device__ __forceinline__ float rsq(float x) { return __builtin_amdgcn_rsqf(x); }

#define XB_TMO      128
#define XB_XCNT(j)  (256  + 64 * (j))
#define XB_XSUB(j)  (1280 + 64 * (j))
#define XB_XGEN(j)  (2304 + 64 * (j))
#define XB_TOP      3328
#define XB_TOPGEN   3392
#define XCD_BAR_WORDS 3456
#define XB_SPIN_CAP (1u << 20)
__device__ __forceinline__ unsigned xb_ld(unsigned* p)              { return __hip_atomic_load(p, __ATOMIC_RELAXED, __HIP_MEMORY_SCOPE_AGENT); }
__device__ __forceinline__ unsigned xb_add(unsigned* p, unsigned v) { return __hip_atomic_fetch_add(p, v, __ATOMIC_RELAXED, __HIP_MEMORY_SCOPE_AGENT); }
__device__ __forceinline__ unsigned xb_xcc_id() { return (unsigned)__builtin_amdgcn_s_getreg((3 << 11) | 20) & 0xFu; }
#define XB_SPIN(cond, bar) do { unsigned _sp = 0; while (cond) { __builtin_amdgcn_s_sleep(1); \
    if ((++_sp & 255u) == 0u) { if (xb_ld(&(bar)[XB_TMO])) break; if (_sp > XB_SPIN_CAP) { atomicAdd(&(bar)[XB_TMO], 1u); break; } } } } while (0)
struct XcdBarrier { unsigned* bar; unsigned x; volatile LAS unsigned* st; };
__device__ __forceinline__ XcdBarrier xcd_barrier_post(unsigned* bar, volatile LAS unsigned* st) {
    XcdBarrier b; b.bar = bar; b.x = xb_xcc_id(); b.st = st;
    if (threadIdx.x == 0) (void)xb_add(&bar[XB_XCNT(b.x)], 1u);
    return b;
}
__device__ __forceinline__ void xcd_barrier_complete(unsigned* bar, unsigned x, unsigned& nloc, unsigned& nx) {
    const unsigned G = gridDim.x * gridDim.y * gridDim.z;
    unsigned sum, cnt, mine, sp = 0u;
    for (;;) {
        sum = 0u; cnt = 0u; mine = 0u;
#pragma unroll
        for (unsigned j = 0; j < 16; ++j) { const unsigned c = xb_ld(&bar[XB_XCNT(j)]); sum += c; cnt += (c > 0u) ? 1u : 0u; mine = (j == x) ? c : mine; }
        if (sum == G) break;
        __builtin_amdgcn_s_sleep(1);
        if ((++sp & 255u) == 0u) { if (xb_ld(&bar[XB_TMO])) break; if (sp > XB_SPIN_CAP) { atomicAdd(&bar[XB_TMO], 1u); break; } }
    }
    nloc = mine > 0u ? mine : 1u; nx = cnt > 0u ? cnt : 1u;
}
__device__ __forceinline__ void xcd_barrier(const XcdBarrier& b) {
    asm volatile("s_waitcnt vmcnt(0)" ::: "memory");
    __syncthreads();
    if (threadIdx.x == 0) {
        unsigned* bar = b.bar;
        __builtin_amdgcn_s_waitcnt(0);
        unsigned nloc = b.st[0], nx = b.st[1];
        if (nloc == 0u) { xcd_barrier_complete(bar, b.x, nloc, nx); b.st[0] = nloc; b.st[1] = nx; }
        const unsigned old = xb_add(&bar[XB_XSUB(b.x)], 1u);
        const unsigned gen = old / nloc;
        if (old + 1u == (gen + 1u) * nloc) {
            __builtin_amdgcn_fence(__ATOMIC_RELEASE, "agent");
            asm volatile("s_waitcnt vmcnt(0)" ::: "memory");
            const unsigned og = xb_add(&bar[XB_TOP], 1u);
            const unsigned tg = og / nx;
            if (og + 1u == (tg + 1u) * nx) xb_add(&bar[XB_TOPGEN], 1u);
            else XB_SPIN(xb_ld(&bar[XB_TOPGEN]) == tg, bar);
            __builtin_amdgcn_fence(__ATOMIC_ACQUIRE, "agent");
            xb_add(&bar[XB_XGEN(b.x)], 1u);
            asm volatile("s_waitcnt vmcnt(0)" ::: "memory");
        } else {
            XB_SPIN(xb_ld(&bar[XB_XGEN(b.x)]) == gen, bar);
            __builtin_amdgcn_fence(__ATOMIC_ACQUIRE, "agent");
            asm volatile("s_waitcnt vmcnt(0)" ::: "memory");
        }
    }
    __syncthreads();
}

#define SP_WORDS 576
#define SP_TOP   512
__device__ __forceinline__ void sp_arrive(const XcdBarrier& b, unsigned* c) {
    asm volatile("s_waitcnt vmcnt(0)" ::: "memory");
    __syncthreads();
    if (threadIdx.x == 0) {
        __builtin_amdgcn_s_waitcnt(0);
        const unsigned nloc = b.st[0];
        const unsigned old = xb_add(&c[32 * b.x], 1u);
        if (old + 1u == nloc) {
            __builtin_amdgcn_fence(__ATOMIC_RELEASE, "agent");
            asm volatile("s_waitcnt vmcnt(0)" ::: "memory");
            xb_add(&c[SP_TOP], 1u);
        }
    }
}

__device__ __forceinline__ void sp_wait(const XcdBarrier& b, unsigned* c) {
    if (threadIdx.x == 0) { const unsigned nx = b.st[1]; XB_SPIN(xb_ld(&c[SP_TOP]) < nx, b.bar); __builtin_amdgcn_fence(__ATOMIC_ACQUIRE, "agent"); asm volatile("s_waitcnt vmcnt(0)" ::: "memory"); }
    __syncthreads();
}

namespace pg {
constexpr int BM = 256, BK = 64, HALF = 128, HTB = HALF * BK * 2, STAGE_BYTES = 8 * HTB, NXCD = 8, WGM = 8;
constexpr int SLAB_B = 131072;
__host__ __device__ __forceinline__ int lds_byte(int r, int c) { const int st = (r >> 4) * 2 + (c >> 5), rr = r & 15, cc = c & 31, ob = rr * 64 + cc * 2; return st * 1024 + (ob ^ (((ob >> 9) & 1) << 5)); }
__host__ __device__ __forceinline__ void stage_rc(int b, int& R, int& C) { const int st = b / 1024, sb = b % 1024, swz = sb ^ (((sb >> 9) & 1) << 5); R = (st >> 1) * 16 + swz / 64; C = (st & 1) * 32 + (swz % 64) / 2; }
__host__ __device__ __forceinline__ int perm32(int rho) { const int n = rho >> 4, i = rho & 15; return 8 * (i >> 2) + 4 * n + (i & 3); }

struct Unit { int pm, pn, kind, sp, uid; };
__device__ __forceinline__ int remap(int L, int nwg) { const int q = nwg / NXCD, r = nwg % NXCD, xcd = L % NXCD, off = L / NXCD; return (xcd < r ? xcd * (q + 1) : r * (q + 1) + (xcd - r) * q) + off; }
__device__ __forceinline__ void tile_from_wgid(int wgid, int nM, int nN, int& pm, int& pn) {
    const int nig = WGM * nN, gid = wgid / nig, fm = gid * WGM, gsz = (nM - fm) < WGM ? (nM - fm) : WGM;
    pm = fm + ((wgid % nig) % gsz); pn = (wgid % nig) / gsz;
}

struct DescPlain {
    static constexpr bool SPLIT = false, HANDOFF = false; static constexpr int S = 1;
    const bf16_t* A; const bf16_t* B; int lda, ldb, nN, ntile;
    __device__ __forceinline__ int total() const { return NPAN * nN; }
    __device__ __forceinline__ void decode(int L, Unit& u) const { tile_from_wgid(remap(L, NPAN * nN), NPAN, nN, u.pm, u.pn); u.kind = 0; u.sp = -1; u.uid = 0; }
    __device__ __forceinline__ const char* a_ptr(const Unit& u) const { return (const char*)(A + (size_t)u.pm * 256 * lda); }
    __device__ __forceinline__ const char* b_ptr(const Unit& u) const { return (const char*)(B + (size_t)u.pn * 256 * ldb); }
    __device__ __forceinline__ int nt(const Unit&) const { return ntile; }
};
struct DescOM {
    static constexpr bool SPLIT = false, HANDOFF = false; static constexpr int S = 1;
    const bf16_t* A; const bf16_t* B; int part; int lda = 512, ldb = 512;
    __device__ __forceinline__ int total() const { return part ? 32 : 512; }
    __device__ __forceinline__ void decode(int L, Unit& u) const { if (part) { u.pm = 32 + (L >> 4); u.pn = L & 15; } else tile_from_wgid(remap(L, 512), 32, 16, u.pm, u.pn); u.kind = 0; u.sp = -1; u.uid = 0; }
    __device__ __forceinline__ const char* a_ptr(const Unit& u) const { return (const char*)(A + (size_t)u.pm * 256 * 512); }
    __device__ __forceinline__ const char* b_ptr(const Unit& u) const { return (const char*)(B + (size_t)u.pn * 256 * 512); }
    __device__ __forceinline__ int nt(const Unit&) const { return 8; }
};
template <int LDA, int LDB, int NN, int NT, int PFULL, int S_>
struct DescTail {
    static constexpr bool SPLIT = true, HANDOFF = true; static constexpr int S = S_, lda = LDA, ldb = LDB, NLEFT = (NPAN - PFULL) * NN;
    const bf16_t* A; const bf16_t* B; const bf16_t* Am; const bf16_t* Bm; int nmem; unsigned char* slab;
    unsigned* wtop = nullptr; unsigned wnx = 0;
    __device__ __forceinline__ int wait_level(const Unit& u) const { return (wtop != nullptr && u.sp >= 0) ? 1 : 0; }
    __device__ __forceinline__ const unsigned* wait_word(int) const { return wtop; }
    __device__ __forceinline__ void unit_of(int uid, Unit& u) const { u.sp = -1; u.uid = uid; u.pm = PFULL + uid / NN; u.pn = uid % NN; u.kind = 0; }
    __device__ __forceinline__ int nfull() const { return PFULL * NN + nmem; }
    __device__ __forceinline__ int total() const { return PFULL * NN + nmem + NLEFT * S; }
    __device__ __forceinline__ void decode(int L, Unit& u) const { const int nf = nfull();
        if (L < nf) { const int w = remap(L, nf); u.sp = -1; u.uid = 0;
            if (w < PFULL * NN) { tile_from_wgid(w, PFULL, NN, u.pm, u.pn); u.kind = 0; } else { u.pm = 0; u.pn = w - PFULL * NN; u.kind = 1; } }
        else { const int j = L - nf; u.sp = j % S; u.uid = j / S; u.pm = PFULL + u.uid / NN; u.pn = u.uid % NN; u.kind = 0; } }
    __device__ __forceinline__ static int kt0(int s) { constexpr int e = NT / 2, b = e / S, r = e % S; return s < 0 ? 0 : 2 * (s * b + (s < r ? s : r)); }
    __device__ __forceinline__ int nt(const Unit& u) const { constexpr int e = NT / 2, b = e / S, r = e % S; return u.sp < 0 ? NT : 2 * (b + (u.sp < r ? 1 : 0)); }
    __device__ __forceinline__ const char* a_ptr(const Unit& u) const { return u.kind ? (const char*)Am : (const char*)(A + (size_t)u.pm * 256 * LDA + kt0(u.sp) * 64); }
    __device__ __forceinline__ const char* b_ptr(const Unit& u) const { return (const char*)((u.kind ? Bm : B) + (size_t)u.pn * 256 * LDB + kt0(u.sp) * 64); }
};
struct DescGU {
    static constexpr bool SPLIT = true, HANDOFF = true; static constexpr int S = 2, lda = 4096, ldb = 4096, NLEFT = 108, NFULL = 2816, NN = 86;
    const bf16_t* A; const bf16_t* B; unsigned char* slab;
    unsigned* wA; unsigned* wB; unsigned wnx;
    __device__ __forceinline__ int wait_level(const Unit& u) const { return u.pm >= 32 ? 2 : 1; }
    __device__ __forceinline__ const unsigned* wait_word(int lv) const { return lv == 2 ? wB : wA; }
    __device__ __forceinline__ void unit_of(int uid, Unit& u) const { u.sp = -1; u.uid = uid; u.pm = 32 + (uid & 1); u.pn = 32 + (uid >> 1); u.kind = 0; }
    __device__ __forceinline__ int total() const { return NFULL + NLEFT * S; }
    __device__ __forceinline__ void decode(int L, Unit& u) const {
        if (L < NFULL) { tile_from_wgid(remap(L, NFULL), NPAN, NN, u.pm, u.pn); u.kind = 0; u.sp = -1; u.uid = 0; }
        else { const int j = L - NFULL; unit_of(j >> 1, u); u.sp = j & 1; } }
    __device__ __forceinline__ int nt(const Unit& u) const { return u.sp < 0 ? 64 : 32; }
    __device__ __forceinline__ const char* a_ptr(const Unit& u) const { return (const char*)(A + (size_t)u.pm * 256 * 4096 + (u.sp > 0 ? 2048 : 0)); }
    __device__ __forceinline__ const char* b_ptr(const Unit& u) const { return (const char*)(B + (size_t)u.pn * 256 * 4096 + (u.sp > 0 ? 2048 : 0)); }
};
struct DescFold {
    static constexpr bool SPLIT = false, HANDOFF = false; static constexpr int S = 1;
    const bf16_t* A; const bf16_t* B; int lda, ldb;
    __device__ __forceinline__ int total() const { return 256; }
    __device__ __forceinline__ void decode(int L, Unit& u) const { u.kind = L >> 5; u.pm = (L >> 1) & 15; u.pn = L & 1; u.sp = -1; u.uid = 0; }
    __device__ __forceinline__ const char* a_ptr(const Unit& u) const { return (const char*)(A + (size_t)(u.kind >> 2) * DM * 2048 + (size_t)u.pm * 256 * 2048 + (u.kind & 3) * 512); }
    __device__ __forceinline__ const char* b_ptr(const Unit& u) const { return (const char*)B + (size_t)(u.kind >> 2) * WL_SIZE + ((size_t)(u.kind & 3) * 512 * 512 + (size_t)u.pn * 256 * 512) * 2; }
    __device__ __forceinline__ int nt(const Unit&) const { return 8; }
};
struct DescSplitK {
    static constexpr bool SPLIT = false, HANDOFF = false; static constexpr int S = 1;
    const bf16_t* A; const bf16_t* B; int lda, ldb;
    __device__ __forceinline__ int total() const { return NPAN * 6; }
    __device__ __forceinline__ void decode(int L, Unit& u) const { tile_from_wgid(remap(L, NPAN * 6), NPAN, 6, u.pm, u.pn); u.kind = 0; u.sp = -1; u.uid = 0; }
    __device__ __forceinline__ const char* a_ptr(const Unit& u) const { return (const char*)(A + (size_t)u.pm * 256 * 4096 + (u.pn >> 1) * 1408); }
    __device__ __forceinline__ const char* b_ptr(const Unit& u) const { return (const char*)(B + (size_t)(u.pn & 1) * 256 * 4096 + (u.pn >> 1) * 1408); }
    __device__ __forceinline__ int nt(const Unit& u) const { return (u.pn >> 1) < 2 ? 22 : 20; }
};


struct EpiInProj {
    static constexpr bool PERM = true;
    const float* __restrict__ ss; const float* __restrict__ ssm; const float* __restrict__ qg; const float* __restrict__ kg;
    bf16_t *Q, *K, *V, *U; float* memraw;
    float *akp, *avp, *plp, *aks, *avs, *pls;
    struct Pre { float ssv; };
    __device__ __forceinline__ Pre pre_load(const Unit& u, int ai, int m, int wr, int wc, int fr, int fq) const { const int rl = ai * HALF + wr * 64 + m * 16 + fr; Pre p; p.ssv = (u.kind == 1) ? ssm[rl] : ss[u.pm * BM + rl]; return p; }
    __device__ __forceinline__ void rowgroup(const f32x4 (&a)[2][2], const Pre& pre, const Unit& u, int ai, int m, int wr, int wc, int fr, int fq) const {
        const int rl = ai * HALF + wr * 64 + m * 16 + fr;
        if (u.kind == 1) {
            float* dst = memraw + (size_t)(u.pn >> 2) * 256 * 1024 + (size_t)rl * 1024 + (u.pn & 3) * 256 + wc * 64 + 8 * fq;
            const float rs = rsq(pre.ssv * (1.0f / 4096.0f) + EPS);
#pragma unroll
            for (int bj = 0; bj < 2; ++bj)
#pragma unroll
                for (int n = 0; n < 2; ++n) *(f32x4*)(dst + 32 * bj + 4 * n) = a[bj][n] * rs;
            return;
        }
        const int pn = u.pn;
        const bool normed = pn < 9;
        bf16_t* dst; int ld, cb; float* fo_p = nullptr; float* fo_s = nullptr; int fo_kind = 0;
        if (pn < 8) { dst = Q; ld = 2048; cb = pn * 256; }
        else if (pn == 8) { dst = K; ld = 256; cb = 0; fo_p = akp; fo_s = aks; fo_kind = 1; }
        else if (pn == 9) { dst = V; ld = 256; cb = 0; fo_p = avp; fo_s = avs; fo_kind = 1; }
        else { dst = U; ld = 2048; cb = (pn - 10) * 256; fo_p = plp; fo_s = pls; fo_kind = 2; }
        const int colw = cb + wc * 64 + 8 * fq;
        const bool fout = (fo_kind != 0) && (u.pm >= 31);
        const int row = u.pm * BM + rl;
        const float rs = rsq(pre.ssv * (1.0f / 4096.0f) + EPS);
        f32x4 v[2][2];
#pragma unroll
        for (int bj = 0; bj < 2; ++bj)
#pragma unroll
            for (int n = 0; n < 2; ++n) v[bj][n] = a[bj][n] * rs;
        if (normed) {
            const float* gp = (pn < 8) ? qg : kg;
            float s = 0.f;
#pragma unroll
            for (int bj = 0; bj < 2; ++bj)
#pragma unroll
                for (int n = 0; n < 2; ++n) { const f32x4 x = v[bj][n]; s += (x[0] * x[0] + x[1] * x[1]) + (x[2] * x[2] + x[3] * x[3]); }
            s += __shfl_xor(s, 16); s += __shfl_xor(s, 32);
            float hs = rsq(s * (1.0f / 64.0f) + EPS); if (pn < 8) hs *= QSCALE;
#pragma unroll
            for (int bj = 0; bj < 2; ++bj)
#pragma unroll
                for (int n = 0; n < 2; ++n) v[bj][n] = v[bj][n] * hs * *(const f32x4*)(gp + 32 * bj + 8 * fq + 4 * n);
        }
        bf16_t* rowp = dst + (size_t)row * ld + colw;
#pragma unroll
        for (int bj = 0; bj < 2; ++bj) { u32x4 w; w.x = cvt_pk_bf16(v[bj][0][0], v[bj][0][1]); w.y = cvt_pk_bf16(v[bj][0][2], v[bj][0][3]); w.z = cvt_pk_bf16(v[bj][1][0], v[bj][1][1]); w.w = cvt_pk_bf16(v[bj][1][2], v[bj][1][3]);
            *(u32x4*)(rowp + 32 * bj) = w; }
        if (fout) {
            float* fp = nullptr;
            if (fo_kind == 1) {
                if (row < MP) { if (row >= MP - 128) fp = fo_p + (size_t)(row - (MP - 128)) * 256; }
                else { const int sr = row - MP; fp = fo_s + (size_t)((sr >> 6) * 128 + 64 + (sr & 63)) * 256; }
            } else {
                if (row < MP) { if (row >= MP - 15) fp = fo_p + (size_t)(row - (MP - 15)) * 2048; }
                else { const int sr = row - MP, t = sr & 63; if (t >= 49) fp = fo_s + (size_t)((sr >> 6) * 15 + (t - 49)) * 2048; }
            }
            if (fp) { fp += colw;
#pragma unroll
                for (int bj = 0; bj < 2; ++bj)
#pragma unroll
                    for (int n = 0; n < 2; ++n) *(f32x4*)(fp + 32 * bj + 4 * n) = v[bj][n]; }
        }
    }
};

struct EpiFold {
    static constexpr bool PERM = true;
    unsigned char* wbase;
    struct Pre {}; __device__ __forceinline__ Pre pre_load(const Unit&, int, int, int, int, int, int) const { return Pre{}; }
    __device__ __forceinline__ void rowgroup(const f32x4 (&a)[2][2], const Pre& pre, const Unit& u, int ai, int m, int wr, int wc, int fr, int fq) const {
        bf16_t* rowp = (bf16_t*)(wbase + (size_t)(u.kind >> 2) * WL_SIZE) + (size_t)(u.pm * BM + ai * HALF + wr * 64 + m * 16 + fr) * DM + 2048 + (u.kind & 3) * 512 + u.pn * BM + wc * 32 + 8 * fq;
#pragma unroll
        for (int bj = 0; bj < 2; ++bj) { const f32x4 v0 = a[bj][0], v1 = a[bj][1];
            u32x4 w; w.x = cvt_pk_bf16(v0[0], v0[1]); w.y = cvt_pk_bf16(v0[2], v0[3]); w.z = cvt_pk_bf16(v1[0], v1[1]); w.w = cvt_pk_bf16(v1[2], v1[3]);
            *(u32x4*)(rowp + bj * HALF) = w; }
    }
};

struct EpiResid {
    static constexpr bool PERM = true;
    bf16_t* xb; float* ss_out; float* yout;
    struct Pre { u32x4 x[2]; };
    __device__ __forceinline__ Pre pre_load(const Unit& u, int ai, int m, int wr, int wc, int fr, int fq) const {
        const bf16_t* xr = xb + (size_t)(u.pm * BM + ai * HALF + wr * 64 + m * 16 + fr) * DM + u.pn * BM + wc * 32 + 8 * fq; Pre p;
#pragma unroll
        for (int bj = 0; bj < 2; ++bj) p.x[bj] = *(const u32x4*)(xr + bj * HALF);
        return p;
    }
    __device__ __forceinline__ void rowgroup(const f32x4 (&a)[2][2], const Pre& pre, const Unit& u, int ai, int m, int wr, int wc, int fr, int fq) const {
        const int rl = ai * HALF + wr * 64 + m * 16 + fr; const size_t orow = (size_t)(u.pm * BM + rl) * DM + u.pn * BM + wc * 32 + 8 * fq;
        float s = 0.f;
#pragma unroll
        for (int bj = 0; bj < 2; ++bj) { const u32x4 xo = pre.x[bj];
            const f32x4 x0 = (f32x4){__uint_as_float(xo.x << 16), __uint_as_float(xo.x & 0xffff0000u), __uint_as_float(xo.y << 16), __uint_as_float(xo.y & 0xffff0000u)} + a[bj][0];
            const f32x4 x1 = (f32x4){__uint_as_float(xo.z << 16), __uint_as_float(xo.z & 0xffff0000u), __uint_as_float(xo.w << 16), __uint_as_float(xo.w & 0xffff0000u)} + a[bj][1];
            if (yout) { *(f32x4*)(yout + orow + bj * HALF) = x0; *(f32x4*)(yout + orow + bj * HALF + 4) = x1; }
            else { u32x4 w; w.x = cvt_pk_bf16(x0[0], x0[1]); w.y = cvt_pk_bf16(x0[2], x0[3]); w.z = cvt_pk_bf16(x1[0], x1[1]); w.w = cvt_pk_bf16(x1[2], x1[3]); *(u32x4*)(xb + orow + bj * HALF) = w;
#pragma unroll
                for (int e = 0; e < 4; ++e) { const float lo = __uint_as_float(w[e] << 16), hi = __uint_as_float(w[e] & 0xffff0000u); s += lo * lo + hi * hi; } } }
        if (!yout) { s += __shfl_xor(s, 16); s += __shfl_xor(s, 32); if (fq == 0) atomicAdd(ss_out + u.pm * BM + rl, s); }
    }
};

struct EpiF32Part {
    static constexpr bool IDEMP = true; static constexpr bool PERM = true;
    bf16_t* C;
    struct Pre {}; __device__ __forceinline__ Pre pre_load(const Unit&, int, int, int, int, int, int) const { return Pre{}; }
    __device__ __forceinline__ void rowgroup(const f32x4 (&a)[2][2], const Pre& pre, const Unit& u, int ai, int m, int wr, int wc, int fr, int fq) const {
        bf16_t* rowp = C + (size_t)(u.pn >> 1) * M * 512 + (u.pn & 1) * BM + wc * 32 + 8 * fq + (size_t)(u.pm * BM + ai * HALF + wr * 64 + m * 16 + fr) * 512;
#pragma unroll
        for (int bj = 0; bj < 2; ++bj) { u32x4 w; w.x = cvt_pk_bf16(a[bj][0][0], a[bj][0][1]); w.y = cvt_pk_bf16(a[bj][0][2], a[bj][0][3]); w.z = cvt_pk_bf16(a[bj][1][0], a[bj][1][1]); w.w = cvt_pk_bf16(a[bj][1][2], a[bj][1][3]);
            *(u32x4*)(rowp + bj * HALF) = w; }
    }
};

struct EpiSwiGLU {
    static constexpr bool PERM = true;
    const float* __restrict__ ss; bf16_t* H;
    struct Pre { float ssv; };
    __device__ __forceinline__ Pre pre_load(const Unit& u, int ai, int m, int wr, int wc, int fr, int fq) const { Pre p; p.ssv = ss[u.pm * BM + ai * HALF + wr * 64 + m * 16 + fr]; return p; }
    __device__ __forceinline__ void rowgroup(const f32x4 (&a)[2][2], const Pre& pre, const Unit& u, int ai, int m, int wr, int wc, int fr, int fq) const {
        const int row = u.pm * BM + ai * HALF + wr * 64 + m * 16 + fr;
        const float rs = rsq(pre.ssv * (1.0f / 4096.0f) + EPS);
        float h[8];
#pragma unroll
        for (int n = 0; n < 2; ++n)
#pragma unroll
            for (int i = 0; i < 4; ++i) { const float g = a[0][n][i] * rs, uu = a[1][n][i] * rs;
                h[n * 4 + i] = g * uu * __builtin_amdgcn_rcpf(1.0f + ex2(-g * LOG2E)); }
        u32x4 w; w.x = cvt_pk_bf16(h[0], h[1]); w.y = cvt_pk_bf16(h[2], h[3]); w.z = cvt_pk_bf16(h[4], h[5]); w.w = cvt_pk_bf16(h[6], h[7]);
        *(u32x4*)(H + (size_t)row * DFF + u.pn * 128 + wc * 32 + 8 * fq) = w;
    }
};

template <class Desc, class Epi, bool ALIGN_EPI>
__device__ __forceinline__ void gemm_phase(LAS unsigned char* lds, const Desc& D, const Epi& E, int G, int c) {
    int tid = threadIdx.x; asm volatile("" : "+v"(tid));
    const int wid = __builtin_amdgcn_readfirstlane(tid >> 6), lane = tid & 63, wr = wid >> 2, wc = wid & 3, fr = lane & 15, fq = lane >> 4;
    unsigned voffA[2], voffB[2];
#pragma unroll
    for (int i = 0; i < 2; ++i) { int R, C; stage_rc(tid * 16 + i * 8192, R, C); const int Rb = Epi::PERM ? ((R & ~31) + perm32(R & 31)) : R;
        voffA[i] = (unsigned)(R * D.lda + C) * 2u; voffB[i] = (unsigned)(Rb * D.ldb + C) * 2u; }
    const size_t kstep = (size_t)(BK * 2);
    const size_t hstepA = (size_t)HALF * D.lda * 2, hstepB = (size_t)HALF * D.ldb * 2;
    const unsigned ldsw = (unsigned)wid * 1024u;
    const int aoff = lds_byte(wr * 64 + fr, fq * 8), boff = lds_byte(wc * 32 + fr, fq * 8);
    const LAS unsigned char* pA = lds + aoff; const LAS unsigned char* pB = lds + 4 * HTB + boff;
    asm volatile("" : "+v"(pA), "+v"(pB));
#define PG8_SA(b, h) (((b) * 2 + (h)) * HTB)
#define PG8_SB(b, h) ((4 + (b) * 2 + (h)) * HTB)
#define PG8_STAGE(bufoff, gbase, voff) do { _Pragma("unroll") for (int _i = 0; _i < 2; ++_i) \
        __builtin_amdgcn_global_load_lds((const unsigned*)((const char*)(gbase) + (voff)[_i]), (LAS unsigned*)(lds + (bufoff) + ldsw + _i * 8192), 16, 0, 0); } while (0)
#define PG8_LDA(dst, b, h) do { _Pragma("unroll") for (int m = 0; m < 4; ++m) _Pragma("unroll") for (int k = 0; k < 2; ++k) dst[m][k] = *(const LAS bf16x8*)(pA + PG8_SA(b, h) + m * 2048 + k * 1024); } while (0)
#define PG8_LDB(dst, b, h) do { _Pragma("unroll") for (int n = 0; n < 2; ++n) _Pragma("unroll") for (int k = 0; k < 2; ++k) dst[n][k] = *(const LAS bf16x8*)(pB + (PG8_SB(b, h) - 4 * HTB) + n * 2048 + k * 1024); } while (0)
#define PG8_MMA(ai, bj, At, Bt) do { __builtin_amdgcn_s_setprio(1); _Pragma("unroll") for (int m = 0; m < 4; ++m) _Pragma("unroll") for (int n = 0; n < 2; ++n) _Pragma("unroll") for (int k = 0; k < 2; ++k) \
        acc[ai][bj][m][n] = __builtin_amdgcn_mfma_f32_16x16x32_bf16(Bt[n][k], At[m][k], acc[ai][bj][m][n], 0, 0, 0); __builtin_amdgcn_s_setprio(0); } while (0)
#define PG8_WAIT_V(n) asm volatile("s_waitcnt vmcnt(" #n ")" ::: "memory")
#define PG8_WAIT_L(n) asm volatile("s_waitcnt lgkmcnt(" #n ")" ::: "memory")
#define PG8_BAR __builtin_amdgcn_s_barrier()
#define PG8_SCHED __builtin_amdgcn_sched_barrier(0)
    const int total = D.total();
    Unit cur, nxt; int ui = 0;
    if (c >= total) return;
    D.decode(c, cur);
    f32x4 acc[2][2][4][2];
#pragma unroll
    for (int a = 0; a < 2; ++a)
#pragma unroll
        for (int b = 0; b < 2; ++b)
#pragma unroll
            for (int m = 0; m < 4; ++m)
#pragma unroll
                for (int n = 0; n < 2; ++n) acc[a][b][m][n] = (f32x4){0.f, 0.f, 0.f, 0.f};
    bf16x8 At[4][2], B0[2][2], B1[2][2];
    const char* cA = D.a_ptr(cur); const char* cB = D.b_ptr(cur);
    int nt = D.nt(cur);
    int acq = 0;
#define PG8_AWAIT(u_) do { if constexpr (Desc::HANDOFF) { const int lv_ = D.wait_level(u_); if (lv_ > acq) { acq = lv_; \
        if (wid == 0) { unsigned sp_ = 0; unsigned* wp_ = const_cast<unsigned*>(D.wait_word(lv_)); \
            while ((unsigned)__builtin_amdgcn_readfirstlane((int)__hip_atomic_load(wp_, __ATOMIC_RELAXED, __HIP_MEMORY_SCOPE_AGENT)) < D.wnx) { __builtin_amdgcn_s_sleep(2); if (++sp_ > (1u << 22)) break; } \
            __builtin_amdgcn_fence(__ATOMIC_ACQUIRE, "agent"); asm volatile("s_waitcnt vmcnt(0)" ::: "memory"); } \
        asm volatile("" ::: "memory"); PG8_BAR; asm volatile("" ::: "memory"); } } } while (0)
    PG8_AWAIT(cur);
    PG8_STAGE(PG8_SB(0, 0), cB, voffB); PG8_STAGE(PG8_SB(0, 1), cB + hstepB, voffB); PG8_STAGE(PG8_SA(0, 0), cA, voffA); PG8_STAGE(PG8_SA(0, 1), cA + hstepA, voffA);
    if (wr == 1) PG8_BAR;
    PG8_WAIT_V(2); PG8_BAR;
    PG8_STAGE(PG8_SB(1, 0), cB + kstep, voffB); PG8_STAGE(PG8_SA(1, 0), cA + kstep, voffA); PG8_STAGE(PG8_SB(1, 1), cB + hstepB + kstep, voffB);
    PG8_WAIT_V(6); PG8_BAR;
    for (;;) {
        const int Ln = (ui + 1) * G + c; const bool has_next = Ln < total;
        if (has_next) D.decode(Ln, nxt);
        const char* nA = has_next ? D.a_ptr(nxt) : cA; const char* nB = has_next ? D.b_ptr(nxt) : cB;
        for (int t = 0; t < nt; t += 2) {
            const bool last = (t == nt - 2);
            if (last && has_next) PG8_AWAIT(nxt);
            const char* a1 = cA + (size_t)(t + 1) * kstep;
            const char* a2 = last ? nA : cA + (size_t)(t + 2) * kstep; const char* b2 = last ? nB : cB + (size_t)(t + 2) * kstep;
            const char* a3 = a2 + kstep; const char* b3 = b2 + kstep;
            PG8_LDB(B0, 0, 0); PG8_LDB(B1, 0, 1); PG8_SCHED; PG8_LDA(At, 0, 0); PG8_STAGE(PG8_SA(1, 1), a1 + hstepA, voffA);
            PG8_WAIT_V(8); PG8_WAIT_L(0); PG8_BAR; PG8_MMA(0, 0, At, B0); PG8_MMA(0, 1, At, B1); PG8_BAR; PG8_SCHED;
            PG8_LDA(At, 0, 1); PG8_STAGE(PG8_SB(0, 0), b2, voffB); PG8_STAGE(PG8_SB(0, 1), b2 + hstepB, voffB); PG8_STAGE(PG8_SA(0, 0), a2, voffA);
            PG8_WAIT_V(8); PG8_WAIT_L(0); PG8_BAR; PG8_MMA(1, 0, At, B0); PG8_MMA(1, 1, At, B1); PG8_BAR; PG8_SCHED;
            PG8_LDB(B0, 1, 0); PG8_LDB(B1, 1, 1); PG8_SCHED; PG8_LDA(At, 1, 0); PG8_STAGE(PG8_SA(0, 1), a2 + hstepA, voffA);
            PG8_WAIT_V(8); PG8_WAIT_L(0); PG8_BAR; PG8_MMA(0, 0, At, B0); PG8_MMA(0, 1, At, B1); PG8_BAR; PG8_SCHED;
            PG8_LDA(At, 1, 1); PG8_STAGE(PG8_SB(1, 0), b3, voffB); PG8_STAGE(PG8_SB(1, 1), b3 + hstepB, voffB); PG8_STAGE(PG8_SA(1, 0), a3, voffA);
            PG8_WAIT_V(8); PG8_WAIT_L(0); PG8_BAR; PG8_MMA(1, 0, At, B0); PG8_MMA(1, 1, At, B1); PG8_BAR; PG8_SCHED;
        }
        if constexpr (ALIGN_EPI) { if (wr == 0) PG8_BAR; }
        { int fr_ = fr, fq_ = fq, wr_ = wr, wc_ = wc, ln_ = lane; asm volatile("" : "+v"(fr_), "+v"(fq_), "+v"(ln_)); asm volatile("" : "+s"(wr_), "+s"(wc_));
          bool slabbed = false;
          if constexpr (Desc::SPLIT) {
              if (cur.sp >= 0) {
                  const __amdgpu_buffer_rsrc_t rs = __builtin_amdgcn_make_buffer_rsrc((void*)(D.slab + (size_t)(cur.uid * Desc::S + cur.sp) * SLAB_B), (short)0, SLAB_B, 0x00020000);
                  const int loff = ((wr_ * 4 + wc_) * 16 * 64 + ln_) * 16;
#pragma unroll
                  for (int rp = 0; rp < 16; ++rp) { const f32x4 a0 = acc[rp >> 3][(rp >> 2) & 1][rp & 3][0], a1 = acc[rp >> 3][(rp >> 2) & 1][rp & 3][1];
                      u32x4 w; w.x = cvt_pk_bf16(a0[0], a0[1]); w.y = cvt_pk_bf16(a0[2], a0[3]); w.z = cvt_pk_bf16(a1[0], a1[1]); w.w = cvt_pk_bf16(a1[2], a1[3]);
                      __builtin_amdgcn_raw_buffer_store_b128(w, rs, loff, rp * 1024, 0); }
                  slabbed = true;
              }
          }
          if (!slabbed) {
              typename Epi::Pre pre[2][4];
#pragma unroll
              for (int ai = 0; ai < 2; ++ai)
#pragma unroll
                  for (int m = 0; m < 4; ++m) pre[ai][m] = E.pre_load(cur, ai, m, wr_, wc_, fr_, fq_);
#pragma unroll
              for (int ai = 0; ai < 2; ++ai)
#pragma unroll
                  for (int m = 0; m < 4; ++m) { const f32x4 v[2][2] = {{acc[ai][0][m][0], acc[ai][0][m][1]}, {acc[ai][1][m][0], acc[ai][1][m][1]}}; E.rowgroup(v, pre[ai][m], cur, ai, m, wr_, wc_, fr_, fq_); }
          } }
        if (!has_next) break;
#pragma unroll
        for (int a = 0; a < 2; ++a)
#pragma unroll
            for (int b = 0; b < 2; ++b)
#pragma unroll
                for (int m = 0; m < 4; ++m)
#pragma unroll
                    for (int n = 0; n < 2; ++n) acc[a][b][m][n] = (f32x4){0.f, 0.f, 0.f, 0.f};
        cur = nxt; cA = nA; cB = nB; ++ui; nt = D.nt(cur);
        if constexpr (ALIGN_EPI) { if (wr == 1) PG8_BAR; }
    }
    PG8_WAIT_V(0);
    if constexpr (!ALIGN_EPI) { if (wr == 0) PG8_BAR; }
    PG8_BAR;
#undef PG8_SA
#undef PG8_SB
#undef PG8_STAGE
#undef PG8_LDA
#undef PG8_LDB
#undef PG8_MMA
#undef PG8_WAIT_V
#undef PG8_WAIT_L
#undef PG8_BAR
#undef PG8_SCHED
#undef PG8_AWAIT
}
template <class Desc, class Epi>
__device__ __forceinline__ void reduce_pass(const Desc& D, const Epi& E, int vcu, int G, int wave, int lane) {
    constexpr int S = Desc::S, NT = Desc::NLEFT * 64, TB = (S >= 4) ? 1 : 2;
    const int gw = vcu * 8 + wave, NGW = G * 8, fr = lane & 15, fq = lane >> 4;
    for (int task0 = gw; task0 < NT; task0 += NGW * TB) {
        u32x4 x[TB][2][S]; typename Epi::Pre pre[TB]; Unit u[TB]; int tk[TB];
#pragma unroll
        for (int t = 0; t < TB; ++t) { const int task = task0 + t * NGW; tk[t] = task;
            if (task < NT) { const int uid = task >> 6, w = (task >> 3) & 7, ai = (task >> 2) & 1, m = task & 3;
                D.unit_of(uid, u[t]);
                const unsigned char* base = D.slab + (size_t)uid * S * SLAB_B + (size_t)(((w * 16 + ai * 8 + m) * 64 + lane) * 16);
#pragma unroll
                for (int bj = 0; bj < 2; ++bj)
#pragma unroll
                    for (int sI = 0; sI < S; ++sI) x[t][bj][sI] = *(const u32x4*)(base + (size_t)sI * SLAB_B + bj * 4096);
                pre[t] = E.pre_load(u[t], ai, m, w >> 2, w & 3, fr, fq); } }
#pragma unroll
        for (int t = 0; t < TB; ++t) { const int task = tk[t];
            if (task < NT) { const int w = (task >> 3) & 7, ai = (task >> 2) & 1, m = task & 3;
                f32x4 v[2][2];
#pragma unroll
                for (int bj = 0; bj < 2; ++bj) { f32x4 s0 = (f32x4){0.f, 0.f, 0.f, 0.f}, s1 = s0;
#pragma unroll
                    for (int sI = 0; sI < S; ++sI) { const u32x4 y = x[t][bj][sI];
                        s0 += (f32x4){__uint_as_float(y.x << 16), __uint_as_float(y.x & 0xffff0000u), __uint_as_float(y.y << 16), __uint_as_float(y.y & 0xffff0000u)};
                        s1 += (f32x4){__uint_as_float(y.z << 16), __uint_as_float(y.z & 0xffff0000u), __uint_as_float(y.w << 16), __uint_as_float(y.w & 0xffff0000u)}; }
                    v[bj][0] = s0; v[bj][1] = s1; }
                E.rowgroup(v, pre[t], u[t], ai, m, w >> 2, w & 3, fr, fq); } }
    }
}
}

template <int MODE>
__device__ __forceinline__ void transpose_item(const float* W, int K, int N, bf16_t* WT, const float* kscale, const float* nscale, int col_off, LAS unsigned char* scr, int item, int lane, int ldt = 0) {
    const int nblk = N / 64, kb = item / nblk, nb = item % nblk, k0 = 64 * kb, n0 = 64 * nb;
    const int r16 = lane & 15, q = lane >> 4;
    const float* src = W + (size_t)(k0 + 2 * q) * N + n0 + 4 * r16;
    f32x4 v[16];
#pragma unroll
    for (int j = 0; j < 16; ++j) v[j] = *(const f32x4*)(src + (size_t)(8 * (j >> 1) + (j & 1)) * N);
    if (nscale) { const f32x4 ns = *(const f32x4*)(nscale + n0 + 4 * r16);
#pragma unroll
        for (int j = 0; j < 16; ++j) v[j] = v[j] * ns; }
    if (kscale) {
#pragma unroll
        for (int i = 0; i < 8; ++i) { const f32x2 g = *(const f32x2*)(kscale + k0 + 8 * i + 2 * q); v[2 * i] = v[2 * i] * g[0]; v[2 * i + 1] = v[2 * i + 1] * g[1]; } }
#pragma unroll
    for (int i = 0; i < 8; ++i)
#pragma unroll
        for (int e = 0; e < 4; ++e) *(LAS unsigned*)(scr + (4 * r16 + e) * 128 + ((i ^ (r16 & 7)) * 16) + q * 4) = cvt_pk_bf16(v[2 * i][e], v[2 * i + 1][e]);
    LDS_WAIT(); asm volatile("" ::: "memory");
    const int c = lane & 7;
#pragma unroll
    for (int j = 0; j < 8; ++j) { const int row = (lane >> 3) + 8 * j; const u32x4 o = *(const LAS u32x4*)(scr + row * 128 + ((c ^ ((row >> 2) & 7)) * 16));
        const int lc = col_off + n0 + row; int dr;
        if (MODE == 0) dr = lc;
        else if (MODE == 1) dr = (lc & ~255) + 128 * ((lc >> 5) & 1) + 32 * ((lc >> 6) & 3) + (lc & 31);
        else if (MODE == 2) dr = 256 * (lc >> 7) + (lc & 127);
        else dr = 256 * (lc >> 7) + 128 + (lc & 127);
        *(u32x4*)(WT + (size_t)dr * (ldt ? ldt : K) + k0 + 8 * c) = o; }
    LDS_WAIT(); asm volatile("" ::: "memory");
}
__device__ __forceinline__ void row_to_bf16_ss(const float* xrow, bf16_t* orow, float* ssp, int lane) {
    const f32x4* xr = (const f32x4*)xrow + lane; u32x2* o8 = (u32x2*)orow + lane; float s = 0.f;
#pragma unroll
    for (int j = 0; j < 16; ++j) { const f32x4 v = xr[64 * j]; s += (v[0] * v[0] + v[1] * v[1]) + (v[2] * v[2] + v[3] * v[3]);
        u32x2 w; w.x = cvt_pk_bf16(v[0], v[1]); w.y = cvt_pk_bf16(v[2], v[3]); o8[64 * j] = w; }
    s = wave_sum(s); if (lane == 0) *ssp = s;
}

struct Args { const float* in[28]; float* out; unsigned char* ws; int ph_lo, ph_hi; };
enum { I_XP = 0, I_XS, I_CAK, I_CAV, I_SPOOL, I_CMK, I_CMV, I_MEMP, I_GMIX, I_WIN, I_QN, I_KN, I_SINK, I_WPOOL, I_PSCALE, I_WOUT, I_GCROSS, I_GMEM, I_WQM, I_WKM, I_WVM, I_QNM, I_KNM, I_WOM, I_GFFN, I_WGATE, I_WUP, I_WDOWN };

#ifndef DEFER_L1
#define DEFER_L1 1
#endif
__device__ __forceinline__ void weights_pass(const Args& a, LAS unsigned char* scr, int gw, int NGW, int lane, int pass) {
    unsigned char* ws = a.ws;
    constexpr int I_IN = 64 * 72, I_PL = 64, I_OUT = 64 * 64, I_QM = 64 * 8, I_OMI = 8 * 64, I_G = 64 * 172, I_DN = 172 * 64;
    constexpr int PER_LAYER = I_IN + I_OUT + 3 * I_QM + I_OMI + 2 * I_G + I_DN;
    for (int it = gw + (pass ? PER_LAYER : 0); it < 2 * PER_LAYER; it += NGW) {
        const int l = it / PER_LAYER; int r = it % PER_LAYER;
        if (DEFER_L1) { const bool early = (l == 0) || (r >= I_IN + I_OUT / 2 && r < I_IN + I_OUT) || (r >= I_IN + I_OUT + I_QM && r < I_IN + I_OUT + 3 * I_QM); if (early != (pass == 0)) continue; }
        else if (pass) continue;
        unsigned char* wl = ws + WS_W + (size_t)l * WL_SIZE;
        if (r < I_IN) { transpose_item<1>(a.in[I_WIN] + (size_t)l * DM * INW, DM, INW, (bf16_t*)(wl + WL_IN), a.in[I_GMIX] + l * DM, nullptr, 0, scr, r, lane); continue; } r -= I_IN;
        if (r < I_OUT / 2) { transpose_item<0>(a.in[I_WOUT] + (size_t)l * DM * DM, 2048, DM, (bf16_t*)(wl + WL_OUT), nullptr, nullptr, 0, scr, r, lane, DM); continue; } r -= I_OUT / 2;
        if (r < I_OUT / 2) { transpose_item<0>(a.in[I_WOUT] + (size_t)l * DM * DM + (size_t)2048 * DM, 2048, DM, (bf16_t*)(ws + WS_WLOW) + (size_t)l * DM * 2048, nullptr, nullptr, 0, scr, r, lane); continue; } r -= I_OUT / 2;
        if (r < I_QM) { transpose_item<0>(a.in[I_WQM] + (size_t)l * DM * MW, DM, MW, (bf16_t*)(wl + WL_Q), a.in[I_GCROSS] + l * DM, nullptr, 0, scr, r, lane); continue; } r -= I_QM;
        if (r < I_QM) { transpose_item<1>(a.in[I_WKM] + (size_t)l * DM * MW, DM, MW, (bf16_t*)(ws + WS_WKV) + (size_t)l * 1024 * DM, a.in[I_GMEM] + l * DM, nullptr, 0, scr, r, lane); continue; } r -= I_QM;
        if (r < I_QM) { transpose_item<1>(a.in[I_WVM] + (size_t)l * DM * MW, DM, MW, (bf16_t*)(ws + WS_WKV) + (size_t)l * 1024 * DM, a.in[I_GMEM] + l * DM, nullptr, 512, scr, r, lane); continue; } r -= I_QM;
        if (r < I_OMI) { transpose_item<0>(a.in[I_WOM] + (size_t)l * MW * DM, MW, DM, (bf16_t*)(wl + WL_OM), nullptr, nullptr, 0, scr, r, lane); continue; } r -= I_OMI;
        if (r < I_G) { transpose_item<2>(a.in[I_WGATE] + (size_t)l * DM * DFF, DM, DFF, (bf16_t*)(wl + WL_GU), a.in[I_GFFN] + l * DM, nullptr, 0, scr, r, lane); continue; } r -= I_G;
        if (r < I_G) { transpose_item<3>(a.in[I_WUP] + (size_t)l * DM * DFF, DM, DFF, (bf16_t*)(wl + WL_GU), a.in[I_GFFN] + l * DM, nullptr, 0, scr, r, lane); continue; } r -= I_G;
        transpose_item<0>(a.in[I_WDOWN] + (size_t)l * DFF * DM, DFF, DM, (bf16_t*)(wl + WL_D), nullptr, nullptr, 0, scr, r, lane);
    }
}
__device__ __forceinline__ void p0_prologue(const Args& a, LAS unsigned char* lds, int vcu, int G, int tid, int wave, int lane) {
    unsigned char* ws = a.ws;
    LAS unsigned char* scr = lds + wave * 16384;
    const int gw = vcu * 8 + wave, NGW = G * 8;
    weights_pass(a, scr, gw, NGW, lane, 0);
    float* ss0 = (float*)(ws + WS_SS); float* ssm = (float*)(ws + WS_SSM);
    for (int m = gw; m < M + NMEM; m += NGW) {
        if (m < MP) row_to_bf16_ss(a.in[I_XP] + (size_t)m * DM, (bf16_t*)(ws + WS_XB) + (size_t)m * DM, ss0 + m, lane);
        else if (m < M) row_to_bf16_ss(a.in[I_XS] + (size_t)(m - MP) * DM, (bf16_t*)(ws + WS_XB) + (size_t)m * DM, ss0 + m, lane);
        else row_to_bf16_ss(a.in[I_MEMP] + (size_t)(m - M) * DM, (bf16_t*)(ws + WS_MEMB) + (size_t)(m - M) * DM, ssm + (m - M), lane);
    }
    const int gt = vcu * 512 + tid, NGT = G * 512;
    for (int i = gt; i < 2 * 4 * 512 * 512 / 4; i += NGT) {
        const int e = i * 4, l = e >> 20, g = (e >> 18) & 3, dd = e & 511;
        const f32x4 w = ((const f32x4*)a.in[I_WPOOL])[i] * *(const f32x4*)(a.in[I_PSCALE] + l * PW + g * 512 + dd);
        u32x2 o; o.x = cvt_pk_bf16(w[0], w[1]); o.y = cvt_pk_bf16(w[2], w[3]);
        *(u32x2*)(ws + WS_W + (size_t)l * WL_SIZE + WL_P + (size_t)(e & 0xfffff) * 2) = o;
    }
    for (int i = gt; i < 2 * 8 * 128 * 256 / 4; i += NGT) {
        const f32x4 kv = ((const f32x4*)a.in[I_CAK])[i], vv = ((const f32x4*)a.in[I_CAV])[i];
        u32x2 w; w.x = cvt_pk_bf16(kv[0], kv[1]); w.y = cvt_pk_bf16(kv[2], kv[3]); ((u32x2*)(ws + WS_CK))[i] = w;
        w.x = cvt_pk_bf16(vv[0], vv[1]); w.y = cvt_pk_bf16(vv[2], vv[3]); ((u32x2*)(ws + WS_CV))[i] = w;
        const int e = i * 4, row = (e >> 8) & 127, lb = e >> 15;
        if (row >= 64) { const size_t o = ((size_t)lb * 128 + (row - 64)) * 256 + (e & 255);
            *(f32x4*)(a.out + O_AKS + o) = kv; *(f32x4*)(a.out + O_AVS + o) = vv; }
    }
    for (int i = gt; i < 2 * 8 * 256 * 512 / 4; i += NGT) {
        const f32x4 kv = ((const f32x4*)a.in[I_CMK])[i], vv = ((const f32x4*)a.in[I_CMV])[i];
        u32x2 w; w.x = cvt_pk_bf16(kv[0], kv[1]); w.y = cvt_pk_bf16(kv[2], kv[3]); ((u32x2*)(ws + WS_MKS))[i] = w;
        w.x = cvt_pk_bf16(vv[0], vv[1]); w.y = cvt_pk_bf16(vv[2], vv[3]); ((u32x2*)(ws + WS_MVS))[i] = w;
    }
}

__device__ __forceinline__ void mem_finalize(const Args& a, int vcu, int G, int wave, int lane) {
    unsigned char* ws = a.ws;
    const int gw = vcu * 8 + wave, NGW = G * 8;
    for (int it = gw; it < 2 * NMEM; it += NGW) {
        const int l = it >> 8, m = it & 255;
        const float* raw = (const float*)(ws + WS_MEMRAW) + ((size_t)l * 256 + m) * 1024;
        const float* kg = a.in[I_KNM] + l * 128;
        float* ok = a.out + O_MKP + ((size_t)l * 256 + m) * 512; float* ov = a.out + O_MVP + ((size_t)l * 256 + m) * 512;
        bf16_t* bk = (bf16_t*)(ws + WS_MKB) + ((size_t)l * 256 + m) * 512; bf16_t* bv = (bf16_t*)(ws + WS_MVB) + ((size_t)l * 256 + m) * 512;
#pragma unroll
        for (int h = 0; h < 4; ++h) { const f32x2 v = *(const f32x2*)(raw + h * 128 + 2 * lane); const float s = wave_sum(v[0] * v[0] + v[1] * v[1]);
            const float hs = rsq(s * (1.0f / 128.0f) + EPS); const f32x2 g = *(const f32x2*)(kg + 2 * lane);
            const f32x2 o = {v[0] * hs * g[0], v[1] * hs * g[1]}; *(f32x2*)(ok + h * 128 + 2 * lane) = o; *(unsigned*)(bk + h * 128 + 2 * lane) = cvt_pk_bf16(o[0], o[1]); }
#pragma unroll
        for (int j = 0; j < 2; ++j) { const f32x4 v = *(const f32x4*)(raw + 512 + j * 256 + 4 * lane); *(f32x4*)(ov + j * 256 + 4 * lane) = v;
            u32x2 w; w.x = cvt_pk_bf16(v[0], v[1]); w.y = cvt_pk_bf16(v[2], v[3]); *(u32x2*)(bv + j * 256 + 4 * lane) = w; }
    }
}

template <int W>
__device__ __forceinline__ void pool_diff_item(const bf16_t* U, bf16_t* Dd, const float* st, int r0, int c0) {
    constexpr int NR = 8 + W - 1;
    u32x4 x[NR];
    if (r0 < MP) {
#pragma unroll
        for (int j = 0; j < NR; ++j) { const int rr = r0 - (W - 1) + j; x[j] = (rr >= 0) ? *(const u32x4*)(U + (size_t)rr * PW + c0) : (u32x4){0u, 0u, 0u, 0u}; }
    } else {
        const int sr = r0 - MP, b = sr >> 6, t0 = sr & 63;
#pragma unroll
        for (int j = 0; j < NR; ++j) { const int idx = t0 - (W - 1) + j;
            if (idx >= 0) x[j] = *(const u32x4*)(U + (size_t)(r0 - (W - 1) + j) * PW + c0);
            else { const float* sp = st + ((size_t)b * 15 + (15 + idx)) * PW + c0; const f32x4 s0 = *(const f32x4*)sp, s1 = *(const f32x4*)(sp + 4);
                x[j] = (u32x4){cvt_pk_bf16(s0[0], s0[1]), cvt_pk_bf16(s0[2], s0[3]), cvt_pk_bf16(s1[0], s1[1]), cvt_pk_bf16(s1[2], s1[3])}; } }
    }
#pragma unroll
    for (int t = 0; t < 8; ++t) {
        const int r = r0 + t;
        float inv = 1.0f / (float)W; if (r < MP && r + 1 < W) inv = 1.0f / (float)(r + 1);
        float sum[8];
#pragma unroll
        for (int e = 0; e < 8; ++e) sum[e] = 0.f;
#pragma unroll
        for (int i = W - 1; i >= 0; --i) { const u32x4 v = x[t + (W - 1) - i];
#pragma unroll
            for (int e = 0; e < 4; ++e) { sum[2 * e] += __uint_as_float(v[e] << 16); sum[2 * e + 1] += __uint_as_float(v[e] & 0xffff0000u); } }
        const u32x4 cur = x[t + (W - 1)]; u32x4 o;
#pragma unroll
        for (int e = 0; e < 4; ++e) o[e] = cvt_pk_bf16(sum[2 * e] * inv - __uint_as_float(cur[e] << 16), sum[2 * e + 1] * inv - __uint_as_float(cur[e] & 0xffff0000u));
        *(u32x4*)(Dd + (size_t)r * DM + c0) = o;
    }
}
__device__ __forceinline__ void pool_diff(const Args& a, int l, int vcu, int G, int tid) {
    unsigned char* ws = a.ws;
    const bf16_t* U = (const bf16_t*)(ws + WS_U); bf16_t* Dd = (bf16_t*)(ws + WS_MIX) + 2048;
    const float* st = a.in[I_SPOOL] + (size_t)l * 8 * 15 * PW;
    int it0, it1;
    if (G == 256) { const int bx = (int)blockIdx.x; const int c0w = bx < 64 ? bx : 64 + 2 * (bx - 64), c1w = bx < 64 ? bx + 1 : 66 + 2 * (bx - 64);
        it0 = ((M / 8) * c0w / 448) * 256; it1 = ((M / 8) * c1w / 448) * 256; }
    else { it0 = (int)(((long)(M / 8) * vcu / G)) * 256; it1 = (int)(((long)(M / 8) * (vcu + 1) / G)) * 256; }
    for (int it = it0 + tid; it < it1; it += 512) {
        const int r0 = (it >> 8) * 8, c0 = (it & 255) * 8, g = __builtin_amdgcn_readfirstlane(c0 >> 9);
        if (g == 0) pool_diff_item<2>(U, Dd, st, r0, c0);
        else if (g == 1) pool_diff_item<4>(U, Dd, st, r0, c0);
        else if (g == 2) pool_diff_item<8>(U, Dd, st, r0, c0);
        else pool_diff_item<16>(U, Dd, st, r0, c0);
    }
}

constexpr int SWA_LD = 144;
constexpr int SWA_K_OFF = 0, SWA_V_OFF = 192 * SWA_LD;
typedef short v4i16_t __attribute__((ext_vector_type(4)));
__device__ __forceinline__ s16x4 lds_tr16(const LAS unsigned char* p) { return __builtin_bit_cast(s16x4, __builtin_amdgcn_ds_read_tr16_b64_v4i16((LAS v4i16_t*)p)); }
struct SwaStage { u32x4 kx[3], vx[3]; bf16x8 qf[2][2]; };
__device__ __forceinline__ void swa_load(SwaStage& S, int L, const bf16_t* Q, const bf16_t* Kb, const bf16_t* Vb, const bf16_t* CK, const bf16_t* CV, int tid, int wid, int lane) {
    const int cidx = L >> 3, kvh = (L >> 1) & 3, hp = L & 1;
    const bool samp = cidx >= 128; const int row0 = samp ? MP + 64 * (cidx - 128) : 64 * cidx;
#pragma unroll
    for (int i = 0; i < 3; ++i) { const int p = tid + 512 * i, kk = p >> 3, pc = p & 7;
        const bf16_t *ks, *vs;
        if (samp && kk < 128) { const size_t o = ((size_t)(cidx - 128) * 128 + kk) * 256 + kvh * 64 + pc * 8; ks = CK + o; vs = CV + o; }
        else { int gr = row0 - 128 + kk; if (gr < 0) gr = 0; const size_t o = (size_t)gr * 256 + kvh * 64 + pc * 8; ks = Kb + o; vs = Vb + o; }
        S.kx[i] = *(const u32x4*)ks; S.vx[i] = *(const u32x4*)vs; }
    const int h = kvh * 8 + wid, fr = lane & 15, fq = lane >> 4;
#pragma unroll
    for (int pi = 0; pi < 2; ++pi)
#pragma unroll
        for (int ds = 0; ds < 2; ++ds) S.qf[pi][ds] = *(const bf16x8*)(Q + (size_t)(row0 + 16 * (2 * hp + pi) + fr) * AW + h * 64 + 32 * ds + 8 * fq);
}
__device__ __forceinline__ void swa_write(const SwaStage& S, LAS unsigned char* buf, int tid) {
#pragma unroll
    for (int i = 0; i < 3; ++i) { const int p = tid + 512 * i, kk = p >> 3, pc = p & 7;
        *(LAS u32x4*)(buf + SWA_K_OFF + kk * SWA_LD + pc * 16) = S.kx[i];
        *(LAS u32x4*)(buf + SWA_V_OFF + kk * SWA_LD + pc * 16) = S.vx[i]; }
}
__device__ __forceinline__ void swa_compute(const LAS unsigned char* buf, int L, const bf16x8 (&qfa)[2][2], const float* sinks, bf16_t* MIX, int wid, int lane) {
    const int cidx = L >> 3, kvh = (L >> 1) & 3, hp = L & 1;
    const bool samp = cidx >= 128;
    const int row0 = samp ? MP + 64 * (cidx - 128) : 64 * cidx;
    const int kk0 = (cidx < 2) ? 128 - 64 * cidx : 0;
    const int h = kvh * 8 + wid, fr = lane & 15, fq = lane >> 4;
    const float slope2 = ex2(-(float)(h + 1) * 0.25f) * LOG2E, sink2 = sinks[h] * LOG2E, nslope = -slope2;
    float ns_cf[4];
#pragma unroll
    for (int r = 0; r < 4; ++r) ns_cf[r] = nslope * (float)(fr - 4 * fq - r);
    const LAS unsigned char* kbase = buf + SWA_K_OFF + fr * SWA_LD + fq * 16;
    const LAS unsigned char* vbase = buf + SWA_V_OFF + (4 * fq + (fr >> 2)) * SWA_LD + (fr & 3) * 8;
    f32x4 s[2][12];
#pragma unroll
    for (int blk = 0; blk < 12; ++blk) {
#pragma unroll
        for (int pi = 0; pi < 2; ++pi) { const float cd = nslope * (float)(16 * (2 * hp + pi + 8 - blk));
#pragma unroll
            for (int r = 0; r < 4; ++r) s[pi][blk][r] = -__builtin_fabsf(ns_cf[r] + cd); }
#pragma unroll
        for (int ds = 0; ds < 2; ++ds) { const bf16x8 kf = *(const LAS bf16x8*)(kbase + blk * 16 * SWA_LD + ds * 64);
#pragma unroll
            for (int pi = 0; pi < 2; ++pi) s[pi][blk] = __builtin_amdgcn_mfma_f32_16x16x32_bf16(kf, qfa[pi][ds], s[pi][blk], 0, 0, 0); } }
    if (kk0 > 0) {
#pragma unroll
        for (int pi = 0; pi < 2; ++pi)
#pragma unroll
            for (int blk = 0; blk < 8; ++blk)
#pragma unroll
                for (int r = 0; r < 4; ++r) if (16 * blk + 4 * fq + r < kk0) s[pi][blk][r] = -1e30f;
    }
    float inv[2], sinkp[2]; bf16x8 pf[2][6];
#pragma unroll
    for (int pi = 0; pi < 2; ++pi) {
        float mx = sink2;
#pragma unroll
        for (int blk = 0; blk < 12; ++blk) { mx = __builtin_fmaxf(__builtin_fmaxf(s[pi][blk][0], s[pi][blk][1]), mx); mx = __builtin_fmaxf(__builtin_fmaxf(s[pi][blk][2], s[pi][blk][3]), mx); }
        mx = __builtin_fmaxf(mx, __shfl_xor(mx, 16)); mx = __builtin_fmaxf(mx, __shfl_xor(mx, 32));
#pragma unroll
        for (int blk = 0; blk < 12; ++blk)
#pragma unroll
            for (int r = 0; r < 4; ++r) s[pi][blk][r] = ex2(s[pi][blk][r] - mx);
        sinkp[pi] = ex2(sink2 - mx);
#pragma unroll
        for (int ks = 0; ks < 6; ++ks) { u32x4 w; w.x = cvt_pk_bf16(s[pi][2 * ks][0], s[pi][2 * ks][1]); w.y = cvt_pk_bf16(s[pi][2 * ks][2], s[pi][2 * ks][3]);
            w.z = cvt_pk_bf16(s[pi][2 * ks + 1][0], s[pi][2 * ks + 1][1]); w.w = cvt_pk_bf16(s[pi][2 * ks + 1][2], s[pi][2 * ks + 1][3]); pf[pi][ks] = __builtin_bit_cast(bf16x8, w); }
    }
    { const bf16x8 ones = {(short)0x3F80, (short)0x3F80, (short)0x3F80, (short)0x3F80, (short)0x3F80, (short)0x3F80, (short)0x3F80, (short)0x3F80};
#pragma unroll
      for (int pi = 0; pi < 2; ++pi) { f32x4 os = (f32x4){0.f, 0.f, 0.f, 0.f};
#pragma unroll
          for (int ks = 0; ks < 6; ++ks) os = __builtin_amdgcn_mfma_f32_16x16x32_bf16(ones, pf[pi][ks], os, 0, 0, 0);
          inv[pi] = 1.0f / (os[0] + sinkp[pi]); } }
#pragma unroll
    for (int db = 0; db < 4; ++db) { f32x4 o[2] = {(f32x4){0.f, 0.f, 0.f, 0.f}, (f32x4){0.f, 0.f, 0.f, 0.f}};
#pragma unroll
        for (int ks = 0; ks < 6; ++ks) { const s16x4 lo = lds_tr16(vbase + (32 * ks) * SWA_LD + db * 32), hi = lds_tr16(vbase + (32 * ks + 16) * SWA_LD + db * 32);
            const bf16x8 vf = {lo[0], lo[1], lo[2], lo[3], hi[0], hi[1], hi[2], hi[3]};
#pragma unroll
            for (int pi = 0; pi < 2; ++pi) o[pi] = __builtin_amdgcn_mfma_f32_16x16x32_bf16(vf, pf[pi][ks], o[pi], 0, 0, 0); }
#pragma unroll
        for (int pi = 0; pi < 2; ++pi) { const size_t qrow = (size_t)(row0 + 16 * (2 * hp + pi) + fr);
            u32x2 w; w.x = cvt_pk_bf16(o[pi][0] * inv[pi], o[pi][1] * inv[pi]); w.y = cvt_pk_bf16(o[pi][2] * inv[pi], o[pi][3] * inv[pi]);
            *(u32x2*)(MIX + qrow * DM + h * 64 + 16 * db + 4 * fq) = w; } }
}
constexpr int SWA_DEP_L = 112 * 8;
__device__ __forceinline__ bool swa_phase(LAS unsigned char* lds, int bx, int G, const bf16_t* Q, const bf16_t* Kb, const bf16_t* Vb, const bf16_t* CK, const bf16_t* CV,
                                          const float* sinks, bf16_t* MIX, int tid, int wid, int lane, const XcdBarrier& b, unsigned* spc) {
    constexpr int NU = 136 * 8, BUFB = 2 * 192 * SWA_LD;
    if (bx >= NU) return false;
    bool acq = false;
    if (bx >= SWA_DEP_L) { sp_wait(b, spc); acq = true; }
    SwaStage S; swa_load(S, bx, Q, Kb, Vb, CK, CV, tid, wid, lane);
    int par = 0;
    for (int L = bx; L < NU; L += G, par ^= 1) {
        if (!acq && L + G >= SWA_DEP_L && L + G < NU) { sp_wait(b, spc); acq = true; }
        LAS unsigned char* buf = lds + par * BUFB;
        swa_write(S, buf, tid);
        bf16x8 qfa[2][2];
#pragma unroll
        for (int pi = 0; pi < 2; ++pi)
#pragma unroll
            for (int ds = 0; ds < 2; ++ds) qfa[pi][ds] = S.qf[pi][ds];
        __syncthreads();
        if (L + G < NU) swa_load(S, L + G, Q, Kb, Vb, CK, CV, tid, wid, lane);
        swa_compute(buf, L, qfa, sinks, MIX, wid, lane);
    }
    __syncthreads();
    return acq;
}

constexpr int CA_LD = 272;
constexpr int CA_K_OFF = 0, CA_V_OFF = 256 * CA_LD;
__device__ __forceinline__ void cross_unit(LAS unsigned char* lds, int rowbase, int nrows, int h, const bf16_t* Km, const bf16_t* Vm, const bf16_t* QP, const float* ss, const float* qg,
                                           bf16_t* OM, int tid, int wid, int lane) {
    const int fr = lane & 15, fq = lane >> 4;
    u32x4 kx[8], vx[8];
#pragma unroll
    for (int i = 0; i < 8; ++i) { const int p = tid + 512 * i, mr = p >> 4, pc = p & 15; const size_t o = (size_t)mr * 512 + h * 128 + pc * 8;
        kx[i] = *(const u32x4*)(Km + o); vx[i] = *(const u32x4*)(Vm + o); }
    u32x4 qraw[2][4][3]; float ssv[2];
#pragma unroll
    for (int pass = 0; pass < 2; ++pass) { const int rl = pass * 128 + wid * 16;
        if (rl < nrows) { const size_t row = (size_t)(rowbase + rl + fr); ssv[pass] = ss[row];
#pragma unroll
            for (int ds = 0; ds < 4; ++ds)
#pragma unroll
                for (int sp = 0; sp < 3; ++sp) qraw[pass][ds][sp] = *(const u32x4*)(QP + (size_t)sp * M * 512 + row * 512 + h * 128 + 32 * ds + 8 * fq); } }
#pragma unroll
    for (int i = 0; i < 8; ++i) { const int p = tid + 512 * i, mr = p >> 4, pc = p & 15;
        *(LAS u32x4*)(lds + CA_K_OFF + mr * CA_LD + pc * 16) = kx[i];
        *(LAS u32x4*)(lds + CA_V_OFF + mr * CA_LD + pc * 16) = vx[i]; }
    __syncthreads();
    const LAS unsigned char* vbase = lds + CA_V_OFF + (4 * fq + (fr >> 2)) * CA_LD + (fr & 3) * 8;
#pragma unroll
    for (int pass = 0; pass < 2; ++pass) {
        const int rl = pass * 128 + wid * 16;
        if (rl < nrows) {
            const size_t row = (size_t)(rowbase + rl + fr);
            const float rs = rsq(ssv[pass] * (1.0f / 4096.0f) + EPS);
            f32x4 qa[4][2]; float sq = 0.f;
#pragma unroll
            for (int ds = 0; ds < 4; ++ds) { f32x4 s0 = (f32x4){0.f, 0.f, 0.f, 0.f}, s1 = s0;
#pragma unroll
                for (int sp = 0; sp < 3; ++sp) { const u32x4 x = qraw[pass][ds][sp];
                    s0 += (f32x4){__uint_as_float(x.x << 16), __uint_as_float(x.x & 0xffff0000u), __uint_as_float(x.y << 16), __uint_as_float(x.y & 0xffff0000u)};
                    s1 += (f32x4){__uint_as_float(x.z << 16), __uint_as_float(x.z & 0xffff0000u), __uint_as_float(x.w << 16), __uint_as_float(x.w & 0xffff0000u)}; }
                const f32x4 v0 = s0 * rs, v1 = s1 * rs; qa[ds][0] = v0; qa[ds][1] = v1;
                sq += (v0[0] * v0[0] + v0[1] * v0[1]) + (v0[2] * v0[2] + v0[3] * v0[3]) + (v1[0] * v1[0] + v1[1] * v1[1]) + (v1[2] * v1[2] + v1[3] * v1[3]); }
            sq += __shfl_xor(sq, 16); sq += __shfl_xor(sq, 32);
            const float hs = rsq(sq * (1.0f / 128.0f) + EPS) * QMSCALE;
            bf16x8 qf[4];
#pragma unroll
            for (int ds = 0; ds < 4; ++ds) { const f32x4 g0 = *(const f32x4*)(qg + 32 * ds + 8 * fq), g1 = *(const f32x4*)(qg + 32 * ds + 8 * fq + 4);
                const f32x4 v0 = qa[ds][0] * hs * g0, v1 = qa[ds][1] * hs * g1;
                u32x4 w; w.x = cvt_pk_bf16(v0[0], v0[1]); w.y = cvt_pk_bf16(v0[2], v0[3]); w.z = cvt_pk_bf16(v1[0], v1[1]); w.w = cvt_pk_bf16(v1[2], v1[3]); qf[ds] = __builtin_bit_cast(bf16x8, w); }
            f32x4 s[16];
#pragma unroll
            for (int blk = 0; blk < 16; ++blk) { s[blk] = (f32x4){0.f, 0.f, 0.f, 0.f};
#pragma unroll
                for (int ds = 0; ds < 4; ++ds) { const bf16x8 kf = *(const LAS bf16x8*)(lds + CA_K_OFF + (16 * blk + fr) * CA_LD + (32 * ds + 8 * fq) * 2);
                    s[blk] = __builtin_amdgcn_mfma_f32_16x16x32_bf16(kf, qf[ds], s[blk], 0, 0, 0); } }
            float mx = -1e30f;
#pragma unroll
            for (int blk = 0; blk < 16; ++blk) { mx = __builtin_fmaxf(__builtin_fmaxf(s[blk][0], s[blk][1]), mx); mx = __builtin_fmaxf(__builtin_fmaxf(s[blk][2], s[blk][3]), mx); }
            mx = __builtin_fmaxf(mx, __shfl_xor(mx, 16)); mx = __builtin_fmaxf(mx, __shfl_xor(mx, 32));
            float sum0 = 0.f, sum1 = 0.f;
#pragma unroll
            for (int blk = 0; blk < 16; ++blk) {
#pragma unroll
                for (int r = 0; r < 4; ++r) s[blk][r] = ex2(s[blk][r] - mx);
                sum0 += s[blk][0] + s[blk][1]; sum1 += s[blk][2] + s[blk][3]; }
            float sum = sum0 + sum1;
            sum += __shfl_xor(sum, 16); sum += __shfl_xor(sum, 32);
            const float inv = 1.0f / sum;
            bf16x8 pf[8];
#pragma unroll
            for (int ks = 0; ks < 8; ++ks) { u32x4 w; w.x = cvt_pk_bf16(s[2 * ks][0], s[2 * ks][1]); w.y = cvt_pk_bf16(s[2 * ks][2], s[2 * ks][3]);
                w.z = cvt_pk_bf16(s[2 * ks + 1][0], s[2 * ks + 1][1]); w.w = cvt_pk_bf16(s[2 * ks + 1][2], s[2 * ks + 1][3]); pf[ks] = __builtin_bit_cast(bf16x8, w); }
#pragma unroll
            for (int db = 0; db < 8; ++db) { f32x4 o = (f32x4){0.f, 0.f, 0.f, 0.f};
#pragma unroll
                for (int ks = 0; ks < 8; ++ks) { const s16x4 lo = lds_tr16(vbase + (32 * ks) * CA_LD + db * 32), hi = lds_tr16(vbase + (32 * ks + 16) * CA_LD + db * 32);
                    const bf16x8 vf = {lo[0], lo[1], lo[2], lo[3], hi[0], hi[1], hi[2], hi[3]};
                    o = __builtin_amdgcn_mfma_f32_16x16x32_bf16(vf, pf[ks], o, 0, 0, 0); }
                u32x2 w; w.x = cvt_pk_bf16(o[0] * inv, o[1] * inv); w.y = cvt_pk_bf16(o[2] * inv, o[3] * inv);
                *(u32x2*)(OM + row * 512 + h * 128 + 16 * db + 4 * fq) = w; }
        }
    }
    __syncthreads();
}

constexpr int N_PHASES = 1 + 12 * DEPTH;
__global__ void __launch_bounds__(512, 2) fwd(Args args) {
    __shared__ __attribute__((aligned(16))) unsigned char lds_raw[LDS_BYTES];
    LAS unsigned char* lds = (LAS unsigned char*)lds_raw;
    volatile LAS unsigned* MISC = (volatile LAS unsigned*)(lds + MISC_OFF);
    const int tid = threadIdx.x, lane = tid & 63, wave = __builtin_amdgcn_readfirstlane(tid >> 6);
    const int G = gridDim.x, bx = blockIdx.x; const int vcu = (G % 8 == 0) ? (bx % 8) * (G / 8) + bx / 8 : bx;
    unsigned char* ws = args.ws;
    unsigned* ctl = (unsigned*)(ws + WS_CTL);
    if (tid < 32) MISC[tid] = 0u;
    __syncthreads();
    XcdBarrier bar; bar.bar = ctl + CW_BAR; bar.x = 0; bar.st = nullptr;
#if !MK_SPLIT
    bar = xcd_barrier_post(ctl + CW_BAR, MISC + 8);
#endif
    const int lo = args.ph_lo, hi = args.ph_hi;
#define IN(k) (lo <= (k) && (k) < hi)
#if MK_SPLIT
#define SEAM(k) do { } while (0)
#else
#define SEAM(k) do { if (IN(k) && IN((k) + 1)) xcd_barrier(bar); } while (0)
#endif
#define FRESH_IDS() int tid_ = threadIdx.x; asm volatile("" : "+v"(tid_)); const int lane_ = tid_ & 63, wave_ = __builtin_amdgcn_readfirstlane(tid_ >> 6)
    float* ssb = (float*)(ws + WS_SS);
    bf16_t* XB = (bf16_t*)(ws + WS_XB); bf16_t* QB = (bf16_t*)(ws + WS_Q); bf16_t* KB = (bf16_t*)(ws + WS_K); bf16_t* VB = (bf16_t*)(ws + WS_V);
    bf16_t* UB = (bf16_t*)(ws + WS_U); bf16_t* MIX = (bf16_t*)(ws + WS_MIX); bf16_t* QP = (bf16_t*)(ws + WS_QP);
    bf16_t* OMB = (bf16_t*)(ws + WS_OM); bf16_t* HB = (bf16_t*)(ws + WS_H);

    if (PH_ON(12) && IN(0)) REP(12) { FRESH_IDS(); p0_prologue(args, lds, vcu, G, tid_, wave_, lane_); }
    SEAM(0);

    for (int l = 0; l < DEPTH; ++l) {
        const int pb = 1 + 12 * l;
        unsigned char* wl = ws + WS_W + (size_t)l * WL_SIZE;
        typedef pg::DescTail<4096, 4096, 18, 64, 28, 2> DIn;
        typedef pg::DescTail<4096, 4096, 16, 64, 32, 8> DOut;
        typedef pg::DescTail<DFF, DFF, 16, 172, 32, 8> DDn;
        if ((PH_ON(0) && IN(pb)) || (PH_ON(1) && IN(pb + 1))) {
            DIn D{XB, (const bf16_t*)(wl + WL_IN), (const bf16_t*)(ws + WS_MEMB), (const bf16_t*)(ws + WS_WKV), l == 0 ? 8 : 0, ws + WS_SLAB, l > 0 ? ctl + CW_SP + 2 * SP_WORDS + SP_TOP : nullptr, MISC[9]};
            pg::EpiInProj E{ssb + (3 * l) * SS_STRIDE, (const float*)(ws + WS_SSM), args.in[I_QN] + l * 64, args.in[I_KN] + l * 64, QB, KB, VB, UB, (float*)(ws + WS_MEMRAW),
                            args.out + O_AKP + (size_t)l * 128 * 256, args.out + O_AVP + (size_t)l * 128 * 256, args.out + O_PLP + (size_t)l * 15 * 2048,
                            args.out + O_AKS + (size_t)l * 8 * 128 * 256, args.out + O_AVS + (size_t)l * 8 * 128 * 256, args.out + O_PLS + (size_t)l * 8 * 15 * 2048};
            if (PH_ON(0) && IN(pb)) REP(0) pg::gemm_phase<DIn, pg::EpiInProj, true>(lds, D, E, G, bx);
            SEAM(pb);
            if (PH_ON(1) && IN(pb + 1)) { FRESH_IDS(); pg::reduce_pass<DIn, pg::EpiInProj>(D, E, vcu, G, wave_, lane_); }
        }
        if (l == 0 && PH_ON(13) && IN(pb + 1)) REP(13) {
            pg::DescFold D{(const bf16_t*)(ws + WS_WLOW), (const bf16_t*)(ws + WS_W + WL_P), 2048, 512};
            pg::EpiFold E{ws + WS_W + WL_OUT};
            pg::gemm_phase<pg::DescFold, pg::EpiFold, true>(lds, D, E, G, bx);
        }
        if (IN(pb + 1)) sp_arrive(bar, ctl + CW_SP + (3 + l) * SP_WORDS);
        if (PH_ON(2) && IN(pb + 2)) REP(2) {
            FRESH_IDS();
            const bf16_t* CK = (const bf16_t*)(ws + WS_CK) + (size_t)l * 8 * 128 * 256; const bf16_t* CV = (const bf16_t*)(ws + WS_CV) + (size_t)l * 8 * 128 * 256;
            if (!swa_phase(lds, bx, G, QB, KB, VB, CK, CV, args.in[I_SINK] + l * NHEAD, MIX, tid_, wave_, lane_, bar, ctl + CW_SP + (3 + l) * SP_WORDS)) sp_wait(bar, ctl + CW_SP + (3 + l) * SP_WORDS);
            pool_diff(args, l, vcu, G, tid_);
            if (l == 0) mem_finalize(args, vcu, G, wave_, lane_);
        }
        SEAM(pb + 2);
        if ((PH_ON(3) && IN(pb + 3)) || (PH_ON(4) && IN(pb + 4))) {
            DOut D{MIX, (const bf16_t*)(wl + WL_OUT), nullptr, nullptr, 0, ws + WS_SLAB};
            pg::EpiResid E{XB, ssb + (3 * l + 1) * SS_STRIDE, nullptr};
            if (PH_ON(3) && IN(pb + 3)) { if (PROBE_DUP == 3) { pg::EpiResid Ed{XB, (float*)(ws + WS_DUMSS), (float*)(ws + WS_DUMX)}; pg::gemm_phase<DOut, pg::EpiResid, true>(lds, D, Ed, G, bx); }
                pg::gemm_phase<DOut, pg::EpiResid, true>(lds, D, E, G, bx); }
            SEAM(pb + 3);
            if (PH_ON(4) && IN(pb + 4)) { FRESH_IDS(); pg::reduce_pass<DOut, pg::EpiResid>(D, E, vcu, G, wave_, lane_); }
        }
        SEAM(pb + 4);
        if (PH_ON(5) && IN(pb + 5)) REP(5) {
            pg::DescSplitK D{XB, (const bf16_t*)(wl + WL_Q), 4096, 4096};
            pg::EpiF32Part E{QP};
            pg::gemm_phase<pg::DescSplitK, pg::EpiF32Part, true>(lds, D, E, G, bx);
        }
        SEAM(pb + 5);
        if (PH_ON(6) && IN(pb + 6)) REP(6) {
            FRESH_IDS();
            const float* ssc = ssb + (3 * l + 1) * SS_STRIDE; const float* qg = args.in[I_QNM] + l * 128;
            for (int L = bx; L < 160; L += G) {
                if (L < 128) cross_unit(lds, (L >> 2) * 256, 256, L & 3, (const bf16_t*)(ws + WS_MKB) + (size_t)l * 256 * 512, (const bf16_t*)(ws + WS_MVB) + (size_t)l * 256 * 512, QP, ssc, qg, OMB, tid_, wave_, lane_);
                else { const int b = (L - 128) >> 2; cross_unit(lds, MP + 64 * b, 64, L & 3, (const bf16_t*)(ws + WS_MKS) + ((size_t)l * 8 + b) * 256 * 512, (const bf16_t*)(ws + WS_MVS) + ((size_t)l * 8 + b) * 256 * 512, QP, ssc, qg, OMB, tid_, wave_, lane_); }
            }
        }
        SEAM(pb + 6);
        if (PH_ON(7) && IN(pb + 7)) {
            pg::EpiResid E{XB, ssb + (3 * l + 2) * SS_STRIDE, nullptr};
            { pg::DescOM D{OMB, (const bf16_t*)(wl + WL_OM), 0}; pg::gemm_phase<pg::DescOM, pg::EpiResid, true>(lds, D, E, G, bx); }
            sp_arrive(bar, ctl + CW_SP + (5 + 2 * l) * SP_WORDS);
            { const int omb = G >= 72 ? G - 40 : 0;
              pg::DescOM D{OMB, (const bf16_t*)(wl + WL_OM), 1}; pg::gemm_phase<pg::DescOM, pg::EpiResid, true>(lds, D, E, G, bx >= omb ? bx - omb : (1 << 20)); }
            sp_arrive(bar, ctl + CW_SP + (6 + 2 * l) * SP_WORDS);
        }
        if ((PH_ON(8) && IN(pb + 8)) || (PH_ON(9) && IN(pb + 9))) {
            pg::DescGU D{XB, (const bf16_t*)(wl + WL_GU), ws + WS_SLAB, ctl + CW_SP + (5 + 2 * l) * SP_WORDS + SP_TOP, ctl + CW_SP + (6 + 2 * l) * SP_WORDS + SP_TOP, MISC[9]};
            pg::EpiSwiGLU E{ssb + (3 * l + 2) * SS_STRIDE, HB};
            if (PH_ON(8) && IN(pb + 8)) REP(8) pg::gemm_phase<pg::DescGU, pg::EpiSwiGLU, true>(lds, D, E, G, bx);
            SEAM(pb + 8);
            if (PH_ON(9) && IN(pb + 9)) { FRESH_IDS(); pg::reduce_pass<pg::DescGU, pg::EpiSwiGLU>(D, E, vcu, G, wave_, lane_); }
        }
        if (DEFER_L1 && l == 0 && IN(pb + 9)) { FRESH_IDS(); weights_pass(args, lds + wave_ * 16384, vcu * 8 + wave_, G * 8, lane_, 1); }
        if (IN(pb + 9)) sp_arrive(bar, ctl + CW_SP + l * SP_WORDS);
        if ((PH_ON(10) && IN(pb + 10)) || (PH_ON(11) && IN(pb + 11))) {
            DDn D{HB, (const bf16_t*)(wl + WL_D), nullptr, nullptr, 0, ws + WS_SLAB, ctl + CW_SP + l * SP_WORDS + SP_TOP, MISC[9]};
            pg::EpiResid E{XB, ssb + (3 * l + 3) * SS_STRIDE, l + 1 < DEPTH ? nullptr : args.out};
            if (PH_ON(10) && IN(pb + 10)) { if (PROBE_DUP == 10) { pg::EpiResid Ed{XB, (float*)(ws + WS_DUMSS), (float*)(ws + WS_DUMX)}; pg::gemm_phase<DDn, pg::EpiResid, true>(lds, D, Ed, G, bx); }
                pg::gemm_phase<DDn, pg::EpiResid, true>(lds, D, E, G, bx); }
            SEAM(pb + 10);
            if (PH_ON(11) && IN(pb + 11)) { FRESH_IDS(); pg::reduce_pass<DDn, pg::EpiResid>(D, E, vcu, G, wave_, lane_); }
        }
        if (l + 1 < DEPTH && IN(pb + 11)) sp_arrive(bar, ctl + CW_SP + 2 * SP_WORDS);
    }
#undef IN
#undef SEAM
#undef FRESH_IDS
}

extern "C" void kernel_launch(void* const* d_in, const int* in_sizes, int n_in, void* d_out, int out_size, void* d_ws, size_t ws_size, hipStream_t stream) {
    static int grid = 0;
    if (grid == 0) {
        if (n_in != 28 || out_size != (int)O_END || ws_size < WS_END) { fprintf(stderr, "kernel_launch: unexpected shapes (n_in %d out %d ws %zu)\n", n_in, out_size, ws_size); grid = -1; return; }
        int dev = 0, cus = 0;
        if (hipGetDevice(&dev) != hipSuccess || hipDeviceGetAttribute(&cus, hipDeviceAttributeMultiprocessorCount, dev) != hipSuccess) { grid = -1; return; }
        int per_cu = 0;
        if (hipOccupancyMaxActiveBlocksPerMultiprocessor(&per_cu, (const void*)fwd, 512, 0) != hipSuccess || per_cu < 1) { fprintf(stderr, "kernel_launch: occupancy query says %d\n", per_cu); }
        (void)hipGetLastError();
        grid = cus;
    }
    if (grid < 0) return;
    (void)hipMemsetAsync((char*)d_ws + WS_CTL, 0, CTL_ZERO_BYTES, stream);
    Args a{};
    for (int i = 0; i < 28; ++i) a.in[i] = (const float*)d_in[i];
    a.out = (float*)d_out; a.ws = (unsigned char*)d_ws;
#if MK_SPLIT
    for (int p = 0; p < N_PHASES; ++p) { a.ph_lo = p; a.ph_hi = p + 1; hipLaunchKernelGGL(fwd, dim3(grid), dim3(512), 0, stream, a); }
#else
    a.ph_lo = 0; a.ph_hi = N_PHASES;
    hipLaunchKernelGGL(fwd, dim3(grid), dim3(512), 0, stream, a);
#endif
}
```
